# Optimizing an MI355X kernel written in HIP

```python
import jax, jax.numpy as jnp
from jax import lax
import numpy as np

D_MODEL = 1024
BATCH = 2
SEQ = 8192
DEPTH = 4
DEC_BATCH = 128
DEC_SEQ = 1
PAST_LEN = 8192
PAGE_SIZE = 128

HEAD_DIM = 64
N_A_HEADS = 8
A_WIDTH = N_A_HEADS * HEAD_DIM
N_Q_HEADS = 8
N_KV_HEADS = 2
GQA_GROUP = N_Q_HEADS // N_KV_HEADS
B_WIDTH = N_Q_HEADS * HEAD_DIM
KV_WIDTH = N_KV_HEADS * HEAD_DIM
MIX_WIDTH = A_WIDTH + B_WIDTH
DECAY_LORA = 64
AAA_LORA = 64
GATE_LORA = 160
A_PROJ = 3 * A_WIDTH + DECAY_LORA + AAA_LORA + GATE_LORA
B_PROJ = B_WIDTH + 2 * KV_WIDTH
IN_PROJ = A_PROJ + B_PROJ
WINDOW = 128
BLOCK = WINDOW
WIN_BUF = min(WINDOW, PAST_LEN)
D_FF = -(-8 * D_MODEL // (3 * 256)) * 256
ROPE_THETA = 10000.0
NORM_EPS = 1e-5
LNX_EPS = 64e-5
ATTN_SCALE = HEAD_DIM ** -0.5

kernel_name = "hybrid_rwkv7_swa_sink_decoder_step"

F32 = jnp.float32


def rmsnorm(x, g):
    xf = x.astype(F32)
    y = xf * lax.rsqrt(jnp.mean(xf * xf, axis=-1, keepdims=True) + NORM_EPS)
    return (y * g.astype(F32)).astype(x.dtype)


def rope(x, positions):
    half = HEAD_DIM // 2
    inv = ROPE_THETA ** (-jnp.arange(half, dtype=F32) / half)
    ang = positions.astype(F32)[:, None] * inv[None, :]
    cos = jnp.cos(ang)[:, None, :]
    sin = jnp.sin(ang)[:, None, :]
    xf = x.astype(F32)
    x1, x2 = xf[..., :half], xf[..., half:]
    return jnp.concatenate([x1 * cos - x2 * sin, x2 * cos + x1 * sin], axis=-1).astype(x.dtype)


def sink_softmax(s, mask, sink):
    s = jnp.where(mask, s, -jnp.inf)
    m = jnp.maximum(jnp.max(s, axis=-1, keepdims=True), sink)
    p = jnp.exp(s - m)
    return p / (jnp.sum(p, axis=-1, keepdims=True) + jnp.exp(sink - m))


def rwkv7_scan(r, decay, k, v, a_, b_, S0):
    def step(S, inp):
        r_t, w_t, k_t, v_t, a_t, b_t = inp
        sa = jnp.einsum('bhij,bhj->bhi', S, a_t)
        S = S * w_t[:, :, None, :] + sa[..., None] * b_t[:, :, None, :] + v_t[..., None] * k_t[:, :, None, :]
        y = jnp.einsum('bhij,bhj->bhi', S, r_t)
        return S, y
    seq = tuple(jnp.swapaxes(t, 0, 1) for t in (r, decay, k, v, a_, b_))
    S, y = lax.scan(step, S0, seq)
    return jnp.swapaxes(y, 0, 1), S


def rwkv7_mix(pa, shift_prev, S0, W, l):
    Bn, T, _ = pa.shape
    prev = jnp.concatenate([shift_prev[:, None].astype(pa.dtype), pa[:, :-1]], axis=1)
    xs = pa + W['mu'][l] * (prev - pa)
    r, k, v, wlo, alo, glo = jnp.split(
        xs, [A_WIDTH, 2 * A_WIDTH, 3 * A_WIDTH, 3 * A_WIDTH + DECAY_LORA, 3 * A_WIDTH + DECAY_LORA + AAA_LORA], axis=-1)
    w = -jax.nn.softplus(-(W['w0'][l] + jnp.tanh(wlo) @ W['w_decay_up'][l]).astype(F32)) - 0.5
    decay = jnp.exp(-jnp.exp(w))
    a = jax.nn.sigmoid((W['a0'][l] + alo @ W['w_a_up'][l]).astype(F32))
    g = jax.nn.sigmoid(glo) @ W['w_g_up'][l]
    hs = lambda t: t.reshape(Bn, T, N_A_HEADS, HEAD_DIM)
    kk = hs((k * W['k_k'][l]).astype(F32))
    kk = kk / jnp.maximum(jnp.sqrt(jnp.sum(kk * kk, axis=-1, keepdims=True)), 1e-12)
    k_mod = k.astype(F32) * (1.0 + (a - 1.0) * W['k_a'][l].astype(F32))
    rh, kh, vh, ah, dh = hs(r.astype(F32)), hs(k_mod), hs(v.astype(F32)), hs(a), hs(decay)
    y, S = rwkv7_scan(rh, dh, kh, vh, -kk, kk * ah, S0.astype(F32))
    mean = jnp.mean(y, axis=-1, keepdims=True)
    var = jnp.mean(jnp.square(y - mean), axis=-1, keepdims=True)
    yn = ((y - mean) * lax.rsqrt(var + LNX_EPS)).reshape(Bn, T, A_WIDTH)
    yn = yn * W['lnx_g'][l].astype(F32) + W['lnx_b'][l].astype(F32)
    bonus = (jnp.sum(rh * kh * W['r_k'][l].astype(F32), axis=-1, keepdims=True) * vh).reshape(Bn, T, A_WIDTH)
    out = (yn + bonus) * g.astype(F32)
    return out.astype(pa.dtype), pa[:, -1], S


def swa_banded(q, k, v, sink):
    Bn, T = q.shape[0], q.shape[1]
    nb = T // BLOCK
    qb = q.reshape(Bn, nb, BLOCK, N_KV_HEADS, GQA_GROUP, HEAD_DIM)

    def band(t):
        tb = t.reshape(Bn, nb, BLOCK, N_KV_HEADS, HEAD_DIM)
        prev = jnp.concatenate([jnp.zeros_like(tb[:, :1]), tb[:, :-1]], axis=1)
        return jnp.concatenate([prev, tb], axis=2)

    kb, vb = band(k), band(v)
    s = jnp.einsum('bnqkgd,bnskd->bnkgqs', qb, kb).astype(F32) * ATTN_SCALE
    i = jnp.arange(BLOCK)
    j = jnp.arange(2 * BLOCK)
    n = jnp.arange(nb)
    diff = i[:, None] - j[None, :] + BLOCK
    kpos = n[:, None] * BLOCK - BLOCK + j[None, :]
    mask = ((diff >= 0) & (diff < WINDOW))[None] & (kpos >= 0)[:, None, :]
    mask = mask[None, :, None, None]
    p = sink_softmax(s, mask, sink[None, None, :, :, None, None])
    o = jnp.einsum('bnkgqs,bnskd->bnqkgd', p.astype(vb.dtype), vb)
    return o.reshape(Bn, T, B_WIDTH)


def swa_step(q, k, v, kbuf, vbuf, sink, positions):
    Bn, T = q.shape[0], q.shape[1]
    kc = jnp.concatenate([kbuf.astype(k.dtype), k], axis=1)
    vc = jnp.concatenate([vbuf.astype(v.dtype), v], axis=1)
    qg = q.reshape(Bn, T, N_KV_HEADS, GQA_GROUP, HEAD_DIM)
    s = jnp.einsum('btkgd,bskd->bkgts', qg, kc).astype(F32) * ATTN_SCALE
    kpos = positions[0] - WIN_BUF + jnp.arange(WIN_BUF + T)
    diff = positions[:, None] - kpos[None, :]
    mask = ((diff >= 0) & (diff < WINDOW))[None, None, None]
    p = sink_softmax(s, mask, sink[None, :, :, None, None])
    o = jnp.einsum('bkgts,bskd->btkgd', p.astype(vc.dtype), vc).reshape(Bn, T, B_WIDTH)
    return o, kc[:, -WIN_BUF:], vc[:, -WIN_BUF:]


def decoder_layer(x, l, positions, shift_prev, S0, kbuf, vbuf, W):
    Bn, T, _ = x.shape
    h = rmsnorm(x, W['attn_norm'][l])
    proj = h @ W['w_in'][l]
    pa, pb = proj[..., :A_PROJ], proj[..., A_PROJ:]
    ya, new_shift, S_new = rwkv7_mix(pa, shift_prev, S0, W, l)
    q = pb[..., :B_WIDTH].reshape(Bn, T, N_Q_HEADS, HEAD_DIM)
    k = pb[..., B_WIDTH:B_WIDTH + KV_WIDTH].reshape(Bn, T, N_KV_HEADS, HEAD_DIM)
    v = pb[..., B_WIDTH + KV_WIDTH:].reshape(Bn, T, N_KV_HEADS, HEAD_DIM)
    q = rope(q, positions)
    k = rope(k, positions)
    sink = W['sinks'][l].reshape(N_KV_HEADS, GQA_GROUP).astype(F32)
    if kbuf is None:
        yb = swa_banded(q, k, v, sink)
        new_k, new_v = k[:, T - WIN_BUF:], v[:, T - WIN_BUF:]
    else:
        yb, new_k, new_v = swa_step(q, k, v, kbuf, vbuf, sink, positions)
    mixed = jnp.concatenate([ya, yb.astype(ya.dtype)], axis=-1) @ W['w_out'][l]
    x = x + mixed
    h2 = rmsnorm(x, W['ffn_norm'][l])
    x = x + (jax.nn.silu(h2 @ W['w_gate'][l]) * (h2 @ W['w_up'][l])) @ W['w_down'][l]
    return x, new_shift, S_new, new_k, new_v


def setup_inputs(seed: int = 0) -> dict:
    key = jax.random.key(seed)
    ks = iter(jax.random.split(key, 32))
    nrm = lambda shape, scale: scale * jax.random.normal(next(ks), shape, F32)
    x_prompt = nrm((BATCH, SEQ, D_MODEL), 1.0)
    x_sample = nrm((DEC_BATCH, DEC_SEQ, D_MODEL), 1.0)
    state_rwkv = nrm((DEPTH, DEC_BATCH, N_A_HEADS, HEAD_DIM, HEAD_DIM), 0.2)
    state_shift = nrm((DEPTH, DEC_BATCH, A_PROJ), 1.0)
    cache_k_win = nrm((DEPTH, DEC_BATCH, WIN_BUF, N_KV_HEADS, HEAD_DIM), 1.0)
    cache_v_win = nrm((DEPTH, DEC_BATCH, WIN_BUF, N_KV_HEADS, HEAD_DIM), 1.0)
    attn_norm = 1.0 + nrm((DEPTH, D_MODEL), 0.02)
    w_in = nrm((DEPTH, D_MODEL, IN_PROJ), D_MODEL ** -0.5)
    mu = jax.random.uniform(next(ks), (DEPTH, A_PROJ), F32)
    w0 = jax.random.uniform(next(ks), (DEPTH, A_WIDTH), F32, -6.0, -0.5)
    w_decay_up = nrm((DEPTH, DECAY_LORA, A_WIDTH), 0.1 * DECAY_LORA ** -0.5)
    a0 = nrm((DEPTH, A_WIDTH), 0.1)
    w_a_up = nrm((DEPTH, AAA_LORA, A_WIDTH), 0.5 * AAA_LORA ** -0.5)
    w_g_up = nrm((DEPTH, GATE_LORA, A_WIDTH), GATE_LORA ** -0.5)
    k_k = 0.85 + nrm((DEPTH, A_WIDTH), 0.05)
    k_a = 1.0 + nrm((DEPTH, A_WIDTH), 0.05)
    r_k = nrm((DEPTH, N_A_HEADS, HEAD_DIM), 0.1)
    lnx_g = 1.0 + nrm((DEPTH, A_WIDTH), 0.02)
    lnx_b = nrm((DEPTH, A_WIDTH), 0.02)
    sinks = nrm((DEPTH, N_Q_HEADS), 0.5)
    w_out = nrm((DEPTH, MIX_WIDTH, D_MODEL), MIX_WIDTH ** -0.5)
    ffn_norm = 1.0 + nrm((DEPTH, D_MODEL), 0.02)
    w_gate = nrm((DEPTH, D_MODEL, D_FF), D_MODEL ** -0.5)
    w_up = nrm((DEPTH, D_MODEL, D_FF), D_MODEL ** -0.5)
    w_down = nrm((DEPTH, D_FF, D_MODEL), D_FF ** -0.5)
    final_norm = 1.0 + nrm((D_MODEL,), 0.02)
    return {"x_prompt": x_prompt, "x_sample": x_sample, "state_rwkv": state_rwkv, "state_shift": state_shift,
            "cache_k_win": cache_k_win, "cache_v_win": cache_v_win, "attn_norm": attn_norm, "w_in": w_in,
            "mu": mu, "w0": w0, "w_decay_up": w_decay_up, "a0": a0, "w_a_up": w_a_up, "w_g_up": w_g_up,
            "k_k": k_k, "k_a": k_a, "r_k": r_k, "lnx_g": lnx_g, "lnx_b": lnx_b, "sinks": sinks,
            "w_out": w_out, "ffn_norm": ffn_norm, "w_gate": w_gate, "w_up": w_up, "w_down": w_down,
            "final_norm": final_norm}


def reference(x_prompt, x_sample, state_rwkv, state_shift, cache_k_win, cache_v_win, attn_norm, w_in, mu, w0,
              w_decay_up, a0, w_a_up, w_g_up, k_k, k_a, r_k, lnx_g, lnx_b, sinks, w_out, ffn_norm, w_gate, w_up,
              w_down, final_norm):
    W = dict(attn_norm=attn_norm, w_in=w_in, mu=mu, w0=w0, w_decay_up=w_decay_up, a0=a0, w_a_up=w_a_up,
             w_g_up=w_g_up, k_k=k_k, k_a=k_a, r_k=r_k, lnx_g=lnx_g, lnx_b=lnx_b, sinks=sinks, w_out=w_out,
             ffn_norm=ffn_norm, w_gate=w_gate, w_up=w_up, w_down=w_down)
    Bp, Tp = x_prompt.shape[0], x_prompt.shape[1]
    Ts = x_sample.shape[1]
    pos_p = jnp.arange(Tp, dtype=jnp.int32)
    pos_s = PAST_LEN + jnp.arange(Ts, dtype=jnp.int32)
    xp, xs = x_prompt, x_sample
    p_S, p_sh, p_k, p_v = [], [], [], []
    s_S, s_sh, s_k, s_v = [], [], [], []
    for l in range(DEPTH):
        shift0 = jnp.zeros((Bp, A_PROJ), xp.dtype)
        S0 = jnp.zeros((Bp, N_A_HEADS, HEAD_DIM, HEAD_DIM), F32)
        xp, sh, S, kw, vw = decoder_layer(xp, l, pos_p, shift0, S0, None, None, W)
        p_S.append(S); p_sh.append(sh); p_k.append(kw); p_v.append(vw)
        xs, sh, S, kw, vw = decoder_layer(xs, l, pos_s, state_shift[l], state_rwkv[l], cache_k_win[l],
                                          cache_v_win[l], W)
        s_S.append(S); s_sh.append(sh); s_k.append(kw); s_v.append(vw)
    y_prompt = rmsnorm(xp, final_norm)
    y_sample = rmsnorm(xs, final_norm)
    return (y_prompt, y_sample, jnp.stack(p_S), jnp.stack(p_sh), jnp.stack(p_k), jnp.stack(p_v),
            jnp.stack(s_S), jnp.stack(s_sh), jnp.stack(s_k), jnp.stack(s_v))
```

```cpp
#if defined(HOST_EMU)
#include "emu.h"
#else
#include <hip/hip_runtime.h>
#include <cstdio>
#include <cstdint>
#include <cmath>
#include <cstring>
#define LAS __attribute__((address_space(3)))
#if defined(__HIP_DEVICE_COMPILE__)
#define GAS __attribute__((address_space(1)))
#else
#define GAS
#endif
#define WAVE_SYNC() asm volatile("s_waitcnt lgkmcnt(0)" ::: "memory")
#define MFMA16(a, b, c) __builtin_amdgcn_mfma_f32_16x16x32_bf16(a, b, c, 0, 0, 0)
#define SHFLX(v, m) __shfl_xor(v, m)
#define SHFL(v, s) __shfl(v, s)
#endif
#define DEV __device__ __forceinline__
#if defined(__HIP_DEVICE_COMPILE__) && !defined(HOST_EMU)
#define NT_LD(p) (*(p))
#define NT_ST(p, v) __builtin_nontemporal_store((v), (p))
#else
#define NT_LD(p) (*(p))
#define NT_ST(p, v) (*(p) = (v))
#endif
#if defined(HOST_EMU)
#define GAS
#endif
#define AS_G(T, p) ((T*)(GAS T*)(p))

#ifndef SEQ
#define SEQ 8192
#endif
#ifndef DEPTH
#define DEPTH 4
#endif
#ifndef DEC_BATCH
#define DEC_BATCH 128
#endif
#ifndef PH_PER_LAUNCH
#define PH_PER_LAUNCH 0
#endif
constexpr int BATCH = 2, D = 1024, A_PROJ = 1824, IN_PROJ = 2592, INP = 2816, FF = 2816, GU = 5632;
constexpr int MP = BATCH * SEQ, MS = DEC_BATCH, MR = MP + MS, PAST_LEN = 8192;
constexpr int NCH = SEQ / 64, NQB = SEQ / 128, NITEM = BATCH * NCH * 8;
constexpr float NORM_EPS = 1e-5f, LNX_EPS = 64e-5f;
static_assert(SEQ % 128 == 0 && MP % 256 == 0 && MS % 16 == 0 && MS <= 128, "shape constraints");
enum { I_XP = 0, I_XS, I_SRWKV, I_SSHIFT, I_CK, I_CV, I_ANORM, I_WIN, I_MU, I_W0, I_WDEC, I_A0, I_WA, I_WG, I_KK, I_KA, I_RK, I_LNG, I_LNB, I_SINK, I_WOUT, I_FNORM, I_WGATE, I_WUP, I_WDOWN, I_FINAL, N_IN };
constexpr size_t O_YP = 0, O_YS = O_YP + (size_t)MP * D, O_PS = O_YS + (size_t)MS * D, O_PSH = O_PS + (size_t)DEPTH * BATCH * 32768,
                 O_PK = O_PSH + (size_t)DEPTH * BATCH * A_PROJ, O_PV = O_PK + (size_t)DEPTH * BATCH * 16384, O_SS = O_PV + (size_t)DEPTH * BATCH * 16384,
                 O_SSH = O_SS + (size_t)DEPTH * MS * 32768, O_SK = O_SSH + (size_t)DEPTH * MS * A_PROJ, O_SV = O_SK + (size_t)DEPTH * MS * 16384,
                 O_END = O_SV + (size_t)DEPTH * MS * 16384;
constexpr size_t al256(size_t x) { return (x + 255) & ~(size_t)255; }
constexpr size_t WS_CTL = 0, CTL_BYTES = 1u << 20;
constexpr size_t WS_WIN = WS_CTL + CTL_BYTES, WS_WOUT = WS_WIN + (size_t)DEPTH * INP * D * 2, WS_WGU = WS_WOUT + (size_t)DEPTH * D * D * 2,
                 WS_WDN = WS_WGU + (size_t)DEPTH * GU * D * 2, WS_WLD = WS_WDN + (size_t)DEPTH * D * FF * 2, WS_WLA = WS_WLD + (size_t)DEPTH * 512 * 64 * 2,
                 WS_WLG = WS_WLA + (size_t)DEPTH * 512 * 64 * 2, WS_ROPE = WS_WLG + (size_t)DEPTH * 512 * 160 * 2,
                 WS_XB = al256(WS_ROPE + (size_t)(SEQ + 1) * 64 * 4), WS_PART = al256(WS_XB + (size_t)MR * D * 2), WS_PARTS = al256(WS_PART + (size_t)MR * 16 * 4), WS_MIX = al256(WS_PARTS + (size_t)MS * 32 * 4),
                 WS_G = al256(WS_MIX + (size_t)MR * D * 2), WS_RKR = al256(WS_G + (size_t)MP * 512 * 2), WS_PROJ = al256(WS_RKR + (size_t)MP * 8 * 4),
                 WS_CHP = al256(WS_PROJ + (size_t)MR * IN_PROJ * 2), WS_CHW = WS_CHP + (size_t)NITEM * 8192, WS_CHM = WS_CHW + (size_t)NITEM * 8192,
                 WS_CHS = WS_CHM + (size_t)NITEM * 8192, WS_CHN = WS_CHS + (size_t)NITEM * 8192, WS_CHG = WS_CHN + (size_t)NITEM * 16384,
                 WS_END0 = al256(WS_CHG + (size_t)NITEM * 256), WS_HID = WS_PROJ  ,
                 WS_END = (WS_HID + (size_t)MR * FF * 2 > WS_END0) ? al256(WS_HID + (size_t)MR * FF * 2) : WS_END0;

typedef unsigned short bf16;
typedef short bf16x8 __attribute__((ext_vector_type(8)));
typedef float f32x4 __attribute__((ext_vector_type(4)));
typedef unsigned u32x4 __attribute__((ext_vector_type(4)));
typedef unsigned u32x2 __attribute__((ext_vector_type(2)));

#if defined(HOST_EMU)
DEV unsigned f2bf(float f) { unsigned u = __builtin_bit_cast(unsigned, f); return (u + 0x7fffu + ((u >> 16) & 1u)) >> 16; }
DEV unsigned pk2(float lo, float hi) { return f2bf(lo) | (f2bf(hi) << 16); }
#else
typedef float f32x2_t __attribute__((ext_vector_type(2))); typedef __bf16 bf16x2_t __attribute__((ext_vector_type(2)));
DEV unsigned pk2(float lo, float hi) { const f32x2_t v = {lo, hi}; const bf16x2_t b = __builtin_convertvector(v, bf16x2_t); return __builtin_bit_cast(unsigned, b); }
DEV unsigned f2bf(float f) { return pk2(f, 0.f) & 0xffffu; }
#endif
DEV float bf2f(unsigned h) { return __builtin_bit_cast(float, (h & 0xffffu) << 16); }
DEV u32x2 pk4(f32x4 v) { u32x2 r; r.x = pk2(v[0], v[1]); r.y = pk2(v[2], v[3]); return r; }
DEV f32x4 up4(u32x2 w) { f32x4 r; r[0] = bf2f(w.x); r[1] = bf2f(w.x >> 16); r[2] = bf2f(w.y); r[3] = bf2f(w.y >> 16); return r; }
DEV float wave_sum(float v) {
#pragma unroll
    for (int o = 1; o < 64; o <<= 1) v += SHFLX(v, o);
    return v; }
DEV float wave_max(float v) {
#pragma unroll
    for (int o = 1; o < 64; o <<= 1) v = fmaxf(v, SHFLX(v, o));
    return v; }
#if defined(HOST_EMU)
DEV float fexp(float x) { return expf(x); }
DEV float flog(float x) { return logf(x); }
DEV float frcp(float x) { return 1.0f / x; }
DEV float frsq(float x) { return 1.0f / sqrtf(x); }
DEV float fexp2(float x) { return exp2f(x); }
#else
DEV float fexp(float x) { return __builtin_amdgcn_exp2f(x * 1.4426950408889634f); }
DEV float flog(float x) { return __builtin_amdgcn_logf(x) * 0.6931471805599453f; }
DEV float frcp(float x) { return __builtin_amdgcn_rcpf(x); }
DEV float fexp2(float x) { return __builtin_amdgcn_exp2f(x); }
DEV float frsq(float x) { return __builtin_amdgcn_rsqf(x); }
#endif
DEV float sigmoidf_(float x) { return frcp(1.0f + fexp(-x)); }
DEV float tanhf_(float x) { return 2.0f * frcp(1.0f + fexp(-2.0f * x)) - 1.0f; }
DEV float softplusf_(float x) { return x > 20.f ? x : flog(1.0f + fexp(x)); }
DEV float siluf_(float x) { return x * frcp(1.0f + fexp(-x)); }
typedef float f32x2 __attribute__((ext_vector_type(2)));
DEV u32x2 swiglu4(f32x4 a, f32x4 b, float rsl, float rs2) {
    const f32x2 g01 = {a[0], a[2]}, u01 = {a[1], a[3]}, g23 = {b[0], b[2]}, u23 = {b[1], b[3]};
    const f32x2 t01 = g01 * rsl, t23 = g23 * rsl; const f32x2 d01 = (f32x2){fexp2(t01.x), fexp2(t01.y)} + 1.0f, d23 = (f32x2){fexp2(t23.x), fexp2(t23.y)} + 1.0f;
    const f32x2 r01 = (f32x2){frcp(d01.x), frcp(d01.y)} * rs2, r23 = (f32x2){frcp(d23.x), frcp(d23.y)} * rs2; const f32x2 h01 = (g01 * u01) * r01, h23 = (g23 * u23) * r23;
    u32x2 w; w.x = pk2(h01.x, h01.y); w.y = pk2(h23.x, h23.y); return w; }
DEV bf16x8 mk8(u32x2 lo, u32x2 hi) { u32x4 w; w.x = lo.x; w.y = lo.y; w.z = hi.x; w.w = hi.y; return __builtin_bit_cast(bf16x8, w); }

namespace pg8 {
constexpr int BM = 256, BK = 64, HALF = 128, HTB = HALF * BK * 2, STAGE_BYTES = 8 * HTB, NXCD = 8, WGM = 8;
__host__ __device__ __forceinline__ int lds_byte(int r, int c) { const int st = (r >> 4) * 2 + (c >> 5), rr = r & 15, cc = c & 31, ob = rr * 64 + cc * 2; return st * 1024 + (ob ^ (((ob >> 9) & 1) << 5)); }
__host__ __device__ __forceinline__ void stage_rc(int b, int& R, int& C) { const int st = b / 1024, sb = b % 1024, swz = sb ^ (((sb >> 9) & 1) << 5); R = (st >> 1) * 16 + swz / 64; C = (st & 1) * 32 + (swz % 64) / 2; }
__host__ __device__ __forceinline__ int perm32(int rho) { const int n = rho >> 4, i = rho & 15; return 8 * (i >> 2) + 4 * n + (i & 3); }
struct Unit { int pm, pn; };
struct Gemm { const bf16* A; const bf16* Bt; int M, N, K; };
struct StaticOrder {
    int nM, nN, nwg, G, c;
    __host__ __device__ void init(int M, int N, int G_, int c_) { nM = M / BM; nN = N / BM; nwg = nM * nN; G = G_; c = c_; }
    __host__ __device__ bool next(int i, Unit& u) const {
        const long L = (long)i * G + c; if (L >= nwg) return false;
        int wgid = (int)L; { const int q = nwg / NXCD, r = nwg % NXCD, xcd = wgid % NXCD, off = wgid / NXCD; wgid = (xcd < r ? xcd * (q + 1) : r * (q + 1) + (xcd - r) * q) + off; }
        const int nig = WGM * nN, gid = wgid / nig, fm = gid * WGM, gsz = (nM - fm) < WGM ? (nM - fm) : WGM;
        u.pm = fm + ((wgid % nig) % gsz); u.pn = (wgid % nig) / gsz; return true;
    }
    __device__ __forceinline__ void a_ready(const Unit&) const {}
    __device__ __forceinline__ void done(const Unit&) const {}
};
#if !defined(HOST_EMU)
template <class Epi, class Sched, bool ALIGN_EPI = false, bool SP2 = false>
__device__ __forceinline__ void gemm_phase(LAS unsigned char* lds, const Gemm g, const Sched& S, const Epi& E, const int tid) {
    const int wid = __builtin_amdgcn_readfirstlane(tid >> 6), lane = tid & 63, wr = wid >> 2, wc = wid & 3, fr = lane & 15, fq = lane >> 4;
    const int K = g.K, nt = K / BK;
    unsigned voffA[2], voffB[2];
#pragma unroll
    for (int i = 0; i < 2; ++i) { int R, C; stage_rc(tid * 16 + i * 8192, R, C); const int Rb = Epi::PERM ? ((R & ~31) + perm32(R & 31)) : R;
        voffA[i] = (unsigned)(R * K + C) * 2u; voffB[i] = (unsigned)(Rb * K + C) * 2u; }
    const size_t kstep = (size_t)(BK * 2);
    const size_t hstep = (size_t)HALF * K * 2;
    const size_t tstep = 2 * hstep;
    const unsigned ldsw = (unsigned)wid * 1024u;
    const int aoff = lds_byte(wr * 64 + fr, fq * 8), boff = lds_byte(wc * 32 + fr, fq * 8);
#define PG8_SA(b, h) (((b) * 2 + (h)) * HTB)
#define PG8_SB(b, h) ((4 + (b) * 2 + (h)) * HTB)
#define PG8_STAGE(bufoff, gbase, voff) do { _Pragma("unroll") for (int _i = 0; _i < 2; ++_i) \
        __builtin_amdgcn_global_load_lds((const unsigned*)((const char*)(gbase) + (voff)[_i]), (LAS unsigned*)(lds + (bufoff) + ldsw + _i * 8192), 16, 0, 0); } while (0)
#define PG8_LDA(dst, b, h) do { _Pragma("unroll") for (int m = 0; m < 4; ++m) _Pragma("unroll") for (int k = 0; k < 2; ++k) dst[m][k] = *(const LAS bf16x8*)(lds + PG8_SA(b, h) + aoff + m * 2048 + k * 1024); } while (0)
#define PG8_LDB(dst, b, h) do { _Pragma("unroll") for (int n = 0; n < 2; ++n) _Pragma("unroll") for (int k = 0; k < 2; ++k) dst[n][k] = *(const LAS bf16x8*)(lds + PG8_SB(b, h) + boff + n * 2048 + k * 1024); } while (0)
#define PG8_MMA(ai, bj, At, Bt) do { __builtin_amdgcn_s_setprio(1); _Pragma("unroll") for (int m = 0; m < 4; ++m) _Pragma("unroll") for (int n = 0; n < 2; ++n) _Pragma("unroll") for (int k = 0; k < 2; ++k) \
        acc[ai][bj][m][n] = __builtin_amdgcn_mfma_f32_16x16x32_bf16(Bt[n][k], At[m][k], acc[ai][bj][m][n], 0, 0, 0); __builtin_amdgcn_s_setprio(0); } while (0)
#define PG8_WAIT_V(n) asm volatile("s_waitcnt vmcnt(" #n ")" ::: "memory")
#define PG8_WAIT_L(n) asm volatile("s_waitcnt lgkmcnt(" #n ")" ::: "memory")
#define PG8_BAR __builtin_amdgcn_s_barrier()
#define PG8_SCHED __builtin_amdgcn_sched_barrier(0)
    Unit cur, nxt; int ui = 0;
    if (!S.next(0, cur)) return;
    f32x4 acc[2][2][4][2];
#pragma unroll
    for (int a = 0; a < 2; ++a)
#pragma unroll
        for (int b = 0; b < 2; ++b)
#pragma unroll
            for (int m = 0; m < 4; ++m)
#pragma unroll
                for (int n = 0; n < 2; ++n) acc[a][b][m][n] = (f32x4){0.f, 0.f, 0.f, 0.f};
    bf16x8 At[4][2], B0[2][2], B1[2][2];
    const char* cA = (const char*)g.A + (size_t)cur.pm * tstep; const char* cB = (const char*)g.Bt + (size_t)cur.pn * tstep;
    S.a_ready(cur);
    if constexpr (SP2) {
        PG8_STAGE(PG8_SB(0, 0), cB, voffB); PG8_STAGE(PG8_SB(0, 1), cB + hstep, voffB); PG8_STAGE(PG8_SA(0, 0), cA, voffA); PG8_STAGE(PG8_SA(0, 1), cA + hstep, voffA);
        if (wr == 1) PG8_BAR;
        PG8_WAIT_V(2); PG8_BAR;
        PG8_STAGE(PG8_SB(1, 0), cB + kstep, voffB); PG8_STAGE(PG8_SA(1, 0), cA + kstep, voffA); PG8_STAGE(PG8_SB(1, 1), cB + hstep + kstep, voffB);
        PG8_WAIT_V(6); PG8_BAR;
    } else {
        PG8_STAGE(PG8_SB(0, 0), cB, voffB); PG8_STAGE(PG8_SA(0, 0), cA, voffA); PG8_STAGE(PG8_SB(0, 1), cB + hstep, voffB); PG8_STAGE(PG8_SA(0, 1), cA + hstep, voffA);
        if (wr == 1) PG8_BAR;
        PG8_WAIT_V(4); PG8_BAR;
        PG8_STAGE(PG8_SB(1, 0), cB + kstep, voffB); PG8_STAGE(PG8_SA(1, 0), cA + kstep, voffA); PG8_STAGE(PG8_SB(1, 1), cB + hstep + kstep, voffB);
        PG8_WAIT_V(6); PG8_BAR;
    }
    for (;;) {
        const bool has_next = S.next(ui + 1, nxt);
        const char* nA = has_next ? (const char*)g.A + (size_t)nxt.pm * tstep : cA; const char* nB = has_next ? (const char*)g.Bt + (size_t)nxt.pn * tstep : cB;
        for (int t = 0; t < nt; t += 2) {
            const bool last = (t == nt - 2);
            const char* a1 = cA + (size_t)(t + 1) * kstep;
            const char* a2 = last ? nA : cA + (size_t)(t + 2) * kstep; const char* b2 = last ? nB : cB + (size_t)(t + 2) * kstep;
            const char* a3 = a2 + kstep; const char* b3 = b2 + kstep;
            if (last && has_next) S.a_ready(nxt);
            if constexpr (SP2) {
            PG8_LDB(B0, 0, 0); PG8_LDB(B1, 0, 1); PG8_SCHED; PG8_LDA(At, 0, 0); PG8_STAGE(PG8_SA(1, 1), a1 + hstep, voffA);
            PG8_WAIT_V(8); PG8_WAIT_L(0); PG8_BAR; PG8_MMA(0, 0, At, B0); PG8_MMA(0, 1, At, B1); PG8_BAR; PG8_SCHED;
            PG8_LDA(At, 0, 1); PG8_STAGE(PG8_SB(0, 0), b2, voffB); PG8_STAGE(PG8_SB(0, 1), b2 + hstep, voffB); PG8_STAGE(PG8_SA(0, 0), a2, voffA);
            PG8_WAIT_V(8); PG8_WAIT_L(0); PG8_BAR; PG8_MMA(1, 0, At, B0); PG8_MMA(1, 1, At, B1); PG8_BAR; PG8_SCHED;
            PG8_LDB(B0, 1, 0); PG8_LDB(B1, 1, 1); PG8_SCHED; PG8_LDA(At, 1, 0); PG8_STAGE(PG8_SA(0, 1), a2 + hstep, voffA);
            PG8_WAIT_V(8); PG8_WAIT_L(0); PG8_BAR; PG8_MMA(0, 0, At, B0); PG8_MMA(0, 1, At, B1); PG8_BAR; PG8_SCHED;
            PG8_LDA(At, 1, 1); PG8_STAGE(PG8_SB(1, 0), b3, voffB); PG8_STAGE(PG8_SB(1, 1), b3 + hstep, voffB); PG8_STAGE(PG8_SA(1, 0), a3, voffA);
            PG8_WAIT_V(8); PG8_WAIT_L(0); PG8_BAR; PG8_MMA(1, 0, At, B0); PG8_MMA(1, 1, At, B1); PG8_BAR; PG8_SCHED;
            } else {
            PG8_LDB(B0, 0, 0); PG8_SCHED; PG8_LDA(At, 0, 0); PG8_STAGE(PG8_SA(1, 1), a1 + hstep, voffA);
            PG8_WAIT_L(8); PG8_BAR; PG8_WAIT_L(0); PG8_MMA(0, 0, At, B0); PG8_BAR; PG8_SCHED;
            PG8_LDB(B1, 0, 1); PG8_STAGE(PG8_SB(0, 0), b2, voffB);
            PG8_BAR; PG8_WAIT_L(0); PG8_MMA(0, 1, At, B1); PG8_BAR;
            PG8_LDA(At, 0, 1); PG8_STAGE(PG8_SA(0, 0), a2, voffA);
            PG8_BAR; PG8_WAIT_L(0); PG8_MMA(1, 0, At, B0); PG8_BAR; PG8_SCHED;
            PG8_STAGE(PG8_SB(0, 1), b2 + hstep, voffB);
            PG8_WAIT_V(6); PG8_BAR; PG8_MMA(1, 1, At, B1); PG8_BAR;
            PG8_LDB(B0, 1, 0); PG8_SCHED; PG8_LDA(At, 1, 0); PG8_STAGE(PG8_SA(0, 1), a2 + hstep, voffA);
            PG8_WAIT_L(8); PG8_BAR; PG8_WAIT_L(0); PG8_MMA(0, 0, At, B0); PG8_BAR; PG8_SCHED;
            PG8_LDB(B1, 1, 1); PG8_STAGE(PG8_SB(1, 0), b3, voffB);
            PG8_BAR; PG8_WAIT_L(0); PG8_MMA(0, 1, At, B1); PG8_BAR;
            PG8_LDA(At, 1, 1); PG8_STAGE(PG8_SA(1, 0), a3, voffA);
            PG8_BAR; PG8_WAIT_L(0); PG8_MMA(1, 0, At, B0); PG8_BAR; PG8_SCHED;
            PG8_STAGE(PG8_SB(1, 1), b3 + hstep, voffB);
            PG8_WAIT_V(6); PG8_BAR; PG8_MMA(1, 1, At, B1); PG8_BAR;
            }
        }
        if constexpr (ALIGN_EPI) { if (wr == 0) PG8_BAR; }
        E(acc, cur, wr, wc, fr, fq); S.done(cur);
        if (!has_next) break;
#pragma unroll
        for (int a = 0; a < 2; ++a)
#pragma unroll
            for (int b = 0; b < 2; ++b)
#pragma unroll
                for (int m = 0; m < 4; ++m)
#pragma unroll
                    for (int n = 0; n < 2; ++n) acc[a][b][m][n] = (f32x4){0.f, 0.f, 0.f, 0.f};
        cur = nxt; cA = nA; cB = nB; ++ui;
        if constexpr (ALIGN_EPI) { if (wr == 1) PG8_BAR; }
    }
    PG8_WAIT_V(0);
    if constexpr (!ALIGN_EPI) { if (wr == 0) PG8_BAR; }
    PG8_BAR;
#undef PG8_SA
#undef PG8_SB
#undef PG8_STAGE
#undef PG8_LDA
#undef PG8_LDB
#undef PG8_MMA
#undef PG8_WAIT_V
#undef PG8_WAIT_L
#undef PG8_BAR
#undef PG8_SCHED
}
#else
template <class Epi, class Sched, bool ALIGN_EPI = false, bool SP2 = false>
inline void gemm_phase(LAS unsigned char* lds, const Gemm g, const Sched& S, const Epi& E, const int tid) {
    const int wid = tid >> 6, lane = tid & 63, wr = wid >> 2, wc = wid & 3, fr = lane & 15, fq = lane >> 4;
    Unit u;
    for (int i = 0; S.next(i, u); ++i) {
        f32x4 acc[2][2][4][2];
        for (int ai = 0; ai < 2; ++ai) for (int bj = 0; bj < 2; ++bj) for (int m = 0; m < 4; ++m) for (int n = 0; n < 2; ++n) for (int e = 0; e < 4; ++e) {
            const int r = 256 * u.pm + 128 * ai + 64 * wr + 16 * m + fr, c = 256 * u.pn + 128 * bj + 32 * wc + 8 * fq + 4 * n + e; float s = 0.f;
            const bf16* a = g.A + (size_t)r * g.K; const bf16* b = g.Bt + (size_t)c * g.K;
            for (int k = 0; k < g.K; ++k) s += bf2f(a[k]) * bf2f(b[k]);
            acc[ai][bj][m][n][e] = s; }
        E(acc, u, wr, wc, fr, fq);
    }
    __syncthreads();
}
#endif
}

DEV float rstd_from_part(const GAS float* part, int row) {
    const GAS f32x4* p = (const GAS f32x4*)(part + (size_t)row * 16); f32x4 a = p[0], b = p[1], c = p[2], d = p[3];
    const float s = ((a[0] + a[1]) + (a[2] + a[3])) + ((b[0] + b[1]) + (b[2] + b[3])) + ((c[0] + c[1]) + (c[2] + c[3])) + ((d[0] + d[1]) + (d[2] + d[3]));
    return frsq(s * (1.0f / D) + NORM_EPS);
}
DEV void rstd4_from_part(const GAS float* part, int row0, float (&rs)[4]) {
    f32x4 pp[4][4];
#pragma unroll
    for (int g = 0; g < 4; ++g) { const GAS f32x4* p = (const GAS f32x4*)(part + (size_t)(row0 + 16 * g) * 16);
#pragma unroll
        for (int j = 0; j < 4; ++j) pp[g][j] = p[j]; }
#pragma unroll
    for (int g = 0; g < 4; ++g) { float s = 0.f;
#pragma unroll
        for (int j = 0; j < 4; ++j) s += (pp[g][j][0] + pp[g][j][1]) + (pp[g][j][2] + pp[g][j][3]);
        rs[g] = frsq(s * (1.0f / D) + NORM_EPS); }
}
DEV float rstd_from_part32(const GAS float* part, int row) {
    const GAS f32x4* p = (const GAS f32x4*)(part + (size_t)row * 32); float s = 0.f;
#pragma unroll
    for (int j = 0; j < 8; ++j) { const f32x4 a = p[j]; s += (a[0] + a[1]) + (a[2] + a[3]); }
    return frsq(s * (1.0f / D) + NORM_EPS);
}
DEV void rstd4_sel(const GAS float* part, const GAS float* parts, int row0, bool sp, float (&rs)[4]) {
    if (!sp) { rstd4_from_part(part, row0, rs); return; }
#pragma unroll
    for (int g = 0; g < 4; ++g) { const int r = row0 + 16 * g; rs[g] = rstd_from_part32(parts, (r < MR ? r : MR - 1) - MP); }
}
struct EpiProj {
    static constexpr bool PERM = true;
    GAS bf16* proj; const GAS float* part; const GAS float* parts;
    DEV void operator()(const f32x4 (&acc)[2][2][4][2], const pg8::Unit& u, int wr, int wc, int fr, int fq) const {
        const bool sp = u.pm * 256 >= MP;
#pragma unroll
        for (int ai = 0; ai < 2; ++ai) { const int row0 = u.pm * 256 + ai * 128 + wr * 64 + fr; if (sp && row0 - fr >= MR) continue;
            float rs[4]; rstd4_sel(part, parts, row0, sp, rs);
#pragma unroll
            for (int m = 0; m < 4; ++m) { const int row = row0 + m * 16; if (sp && row >= MR) continue;
#pragma unroll
                for (int bj = 0; bj < 2; ++bj) { const int col0 = u.pn * 256 + bj * 128 + wc * 32 + 8 * fq;
                    if (col0 < IN_PROJ) { const u32x2 a = pk4(acc[ai][bj][m][0] * rs[m]), b = pk4(acc[ai][bj][m][1] * rs[m]); u32x4 w; w.x = a.x; w.y = a.y; w.z = b.x; w.w = b.y;
                        *(GAS u32x4*)(proj + (size_t)row * IN_PROJ + col0) = w; } } } }
    }
};
template <bool F32OUT> struct EpiResid {
    static constexpr bool PERM = true;
    GAS float* xout; GAS bf16* xb; GAS float* part;
    DEV void operator()(const f32x4 (&acc)[2][2][4][2], const pg8::Unit& u, int wr, int wc, int fr, int fq) const {
#pragma unroll
        for (int ai = 0; ai < 2; ++ai) { const int row0 = u.pm * 256 + ai * 128 + wr * 64 + fr; u32x4 xo[4][2];
#pragma unroll
            for (int m = 0; m < 4; ++m)
#pragma unroll
                for (int bj = 0; bj < 2; ++bj) xo[m][bj] = *(const GAS u32x4*)(xb + (size_t)(row0 + 16 * m) * D + u.pn * 256 + bj * 128 + wc * 32 + 8 * fq);
#pragma unroll
            for (int m = 0; m < 4; ++m) { const int row = row0 + 16 * m; float ss = 0.f;
#pragma unroll
                for (int bj = 0; bj < 2; ++bj) { const size_t o = (size_t)row * D + u.pn * 256 + bj * 128 + wc * 32 + 8 * fq;
                    f32x4 x0 = up4((u32x2){xo[m][bj].x, xo[m][bj].y}) + acc[ai][bj][m][0], x1 = up4((u32x2){xo[m][bj].z, xo[m][bj].w}) + acc[ai][bj][m][1];
                    if (F32OUT) { *(GAS f32x4*)(xout + o) = x0; *(GAS f32x4*)(xout + o + 4) = x1; }
                    const u32x2 a = pk4(x0), b = pk4(x1); u32x4 w; w.x = a.x; w.y = a.y; w.z = b.x; w.w = b.y; *(GAS u32x4*)(xb + o) = w;
                    x0 = up4(a); x1 = up4(b);
                    ss += (x0[0] * x0[0] + x0[1] * x0[1]) + (x0[2] * x0[2] + x0[3] * x0[3]) + (x1[0] * x1[0] + x1[1] * x1[1]) + (x1[2] * x1[2] + x1[3] * x1[3]); }
                ss += SHFLX(ss, 16); ss += SHFLX(ss, 32);
                if (fq == 0) part[(size_t)row * 16 + u.pn * 4 + wc] = ss; } }
    }
};
struct EpiGU {
    static constexpr bool PERM = true;
    GAS bf16* hid; const GAS float* part; const GAS float* parts;
    DEV void operator()(const f32x4 (&acc)[2][2][4][2], const pg8::Unit& u, int wr, int wc, int fr, int fq) const {
        const bool sp = u.pm * 256 >= MP;
#pragma unroll
        for (int ai = 0; ai < 2; ++ai) { const int row0 = u.pm * 256 + ai * 128 + wr * 64 + fr; if (sp && row0 - fr >= MR) continue;
            float rs[4]; rstd4_sel(part, parts, row0, sp, rs);
#pragma unroll
            for (int m = 0; m < 4; ++m) { const int row = row0 + m * 16; if (sp && row >= MR) continue;
#pragma unroll
                for (int bj = 0; bj < 2; ++bj) { const int col0 = u.pn * 256 + bj * 128 + wc * 32 + 8 * fq;
                    *(GAS u32x2*)(hid + (size_t)row * FF + (col0 >> 1)) = swiglu4(acc[ai][bj][m][0], acc[ai][bj][m][1], rs[m] * -1.4426950408889634f, rs[m] * rs[m]); } } }
    }
};

template <class Epi> DEV void skinny_gemm(LAS unsigned char* lds, const GAS bf16* A, const GAS bf16* Bt, int K, int N, const Epi& E, int tid, int nidle) {
    const int nit = (N + 31) / 32, lane = tid & 63, w = tid >> 6, fr = lane & 15, fq = lane >> 4, mp = w & 3, kh = w >> 2, nks = K / 64;
    constexpr int NMT = MS / 16;
    const int nworkers = (nidle > 0 && nidle <= (int)gridDim.x) ? nidle : (int)gridDim.x;
    if ((int)gridDim.x - 1 - (int)blockIdx.x >= nworkers) return;
    for (int it = (int)gridDim.x - 1 - (int)blockIdx.x; it < nit; it += nworkers) {
        f32x4 acc[2][2];
#pragma unroll
        for (int i = 0; i < 2; ++i)
#pragma unroll
            for (int j = 0; j < 2; ++j) acc[i][j] = (f32x4){0.f, 0.f, 0.f, 0.f};
        const int m0 = (2 * mp < NMT) ? 2 * mp : 0, m1 = (2 * mp + 1 < NMT) ? 2 * mp + 1 : m0;
        const GAS bf16* ap0 = A + (size_t)(16 * m0 + fr) * K + kh * (K / 2) + 8 * fq; const GAS bf16* ap1 = A + (size_t)(16 * m1 + fr) * K + kh * (K / 2) + 8 * fq;
        const GAS bf16* bp0 = Bt + (size_t)(32 * it + fr) * K + kh * (K / 2) + 8 * fq; const GAS bf16* bp1 = bp0 + (size_t)16 * K;
        for (int kb = 0; kb < nks; kb += 4) {
            bf16x8 a0[4], a1[4], b0[4], b1[4];
#pragma unroll
            for (int s = 0; s < 4; ++s) { a0[s] = *(const GAS bf16x8*)(ap0 + 32 * (kb + s)); a1[s] = *(const GAS bf16x8*)(ap1 + 32 * (kb + s)); b0[s] = *(const GAS bf16x8*)(bp0 + 32 * (kb + s)); b1[s] = *(const GAS bf16x8*)(bp1 + 32 * (kb + s)); }
#pragma unroll
            for (int s = 0; s < 4; ++s) { acc[0][0] = MFMA16(b0[s], a0[s], acc[0][0]); acc[0][1] = MFMA16(b1[s], a0[s], acc[0][1]); acc[1][0] = MFMA16(b0[s], a1[s], acc[1][0]); acc[1][1] = MFMA16(b1[s], a1[s], acc[1][1]); }
        }
        if (kh == 1) {
#pragma unroll
            for (int i = 0; i < 2; ++i)
#pragma unroll
                for (int j = 0; j < 2; ++j) *(LAS f32x4*)(lds + ((mp * 4 + i * 2 + j) * 64 + lane) * 16) = acc[i][j]; }
        __syncthreads();
        if (kh == 0) {
#pragma unroll
            for (int i = 0; i < 2; ++i) {
#pragma unroll
                for (int j = 0; j < 2; ++j) acc[i][j] += *(const LAS f32x4*)(lds + ((mp * 4 + i * 2 + j) * 64 + lane) * 16);
                if (2 * mp + i < NMT) E(acc[i], 16 * (2 * mp + i) + fr, 32 * it + 4 * fq, fq); } }
        __syncthreads();
    }
}
template <int K, class Epi> DEV void skinny_gemm_k8(LAS unsigned char* lds, const GAS bf16* A, const GAS bf16* Bt, int N, const Epi& E, int tid) {
    constexpr int NMT = MS / 16, KS = K / 8, NK = KS / 32; static_assert(KS % 32 == 0, "K/8 must be a multiple of 32");
    const int ncg = N / 32, nit = NMT * ncg, lane = tid & 63, w = tid >> 6, fr = lane & 15, fq = lane >> 4;
    for (int it = (int)gridDim.x - 1 - (int)blockIdx.x; it < nit; it += (int)gridDim.x) {
        const int mt = it % NMT, cgp = it / NMT;
        const GAS bf16* ap = A + (size_t)(16 * mt + fr) * K + w * KS + 8 * fq; const GAS bf16* bp0 = Bt + (size_t)(32 * cgp + fr) * K + w * KS + 8 * fq; const GAS bf16* bp1 = bp0 + (size_t)16 * K;
        bf16x8 a[NK], b0[NK], b1[NK];
#pragma unroll
        for (int s = 0; s < NK; ++s) { a[s] = *(const GAS bf16x8*)(ap + 32 * s); b0[s] = *(const GAS bf16x8*)(bp0 + 32 * s); b1[s] = *(const GAS bf16x8*)(bp1 + 32 * s); }
        f32x4 acc[2] = {(f32x4){0.f, 0.f, 0.f, 0.f}, (f32x4){0.f, 0.f, 0.f, 0.f}};
#pragma unroll
        for (int s = 0; s < NK; ++s) { acc[0] = MFMA16(b0[s], a[s], acc[0]); acc[1] = MFMA16(b1[s], a[s], acc[1]); }
        if (w > 0) { *(LAS f32x4*)(lds + ((w * 2 + 0) * 64 + lane) * 16) = acc[0]; *(LAS f32x4*)(lds + ((w * 2 + 1) * 64 + lane) * 16) = acc[1]; }
        __syncthreads();
        if (w == 0) {
#pragma unroll
            for (int ww = 1; ww < 8; ++ww) { acc[0] += *(const LAS f32x4*)(lds + ((ww * 2 + 0) * 64 + lane) * 16); acc[1] += *(const LAS f32x4*)(lds + ((ww * 2 + 1) * 64 + lane) * 16); }
            E(acc, 16 * mt + fr, 32 * cgp + 4 * fq, fq); }
        __syncthreads();
    }
}
struct SkProj { GAS bf16* proj; const GAS float* part;
    DEV void operator()(const f32x4 (&acc)[2], int row, int col0, int fq) const { const float rs = rstd_from_part32(part, row);
#pragma unroll
        for (int nt = 0; nt < 2; ++nt) { const int c = col0 + 16 * nt; if (c < IN_PROJ) *(GAS u32x2*)(proj + (size_t)row * IN_PROJ + c) = pk4(acc[nt] * rs); } } };
template <bool F32OUT> struct SkResid { GAS float* xout; GAS bf16* xb; GAS float* part;
    DEV void operator()(const f32x4 (&acc)[2], int row, int col0, int fq) const { float ss = 0.f;
#pragma unroll
        for (int nt = 0; nt < 2; ++nt) { const size_t o = (size_t)row * D + col0 + 16 * nt; f32x4 x = up4(*(const GAS u32x2*)(xb + o)) + acc[nt];
            if (F32OUT) *(GAS f32x4*)(xout + o) = x;
            const u32x2 pk = pk4(x); *(GAS u32x2*)(xb + o) = pk; x = up4(pk);
            ss += (x[0] * x[0] + x[1] * x[1]) + (x[2] * x[2] + x[3] * x[3]); }
        ss += SHFLX(ss, 16); ss += SHFLX(ss, 32);
        if (fq == 0) part[(size_t)row * 32 + (col0 >> 5)] = ss; } };
struct SkGU { GAS bf16* hid; const GAS float* part;
    DEV void operator()(const f32x4 (&acc)[2], int row, int col0, int fq) const { const float rs = rstd_from_part32(part, row);
#pragma unroll
        for (int nt = 0; nt < 2; ++nt) { const f32x4 a = acc[nt] * rs; *(GAS unsigned*)(hid + (size_t)row * FF + ((col0 + 16 * nt) >> 1)) = pk2(siluf_(a[0]) * a[1], siluf_(a[2]) * a[3]); } } };

constexpr int NWAVES = 8, LDS_BYTES = 147456, MISC_OFF = 131072 + 320;
struct Args { const float* in[N_IN]; float* out; unsigned char* ws; int ph_lo, ph_hi; };
struct Ctx {
    const float* const* in; float* out; unsigned char* ws; LAS unsigned char* lds; int tid, lane, wave, G, bid, qsel;
};
#define WSP(T, off) ((GAS T*)(C.ws + (off)))
#define GIN(i) ((const GAS float*)C.in[i])
#define GOUT ((GAS float*)C.out)

#if !defined(HOST_EMU)
#define XB_TMO      128
#define XB_XCNT(j)  (256  + 64 * (j))
#define XB_XSUB(j)  (1280 + 64 * (j))
#define XB_XGEN(j)  (2304 + 64 * (j))
#define XB_TOP      3328
#define XB_TOPGEN   3392
#define XCD_BAR_WORDS 3456
#define XB_SPIN_CAP (1u << 22)
__device__ __forceinline__ unsigned xb_ld(unsigned* p)              { return __hip_atomic_load(p, __ATOMIC_RELAXED, __HIP_MEMORY_SCOPE_AGENT); }
__device__ __forceinline__ unsigned xb_add(unsigned* p, unsigned v) { return __hip_atomic_fetch_add(p, v, __ATOMIC_RELAXED, __HIP_MEMORY_SCOPE_AGENT); }
__device__ __forceinline__ unsigned xb_xcc_id() { return (unsigned)__builtin_amdgcn_s_getreg((3 << 11) | 20) & 0xFu; }
#define XB_SPIN(cond, bar) do { unsigned _sp = 0; while (cond) { __builtin_amdgcn_s_sleep(1); \
    if ((++_sp & 255u) == 0u) { if (xb_ld(&(bar)[XB_TMO])) break; if (_sp > XB_SPIN_CAP) { atomicAdd(&(bar)[XB_TMO], 1u); break; } } } } while (0)
struct XcdBarrier { unsigned* bar; unsigned x; volatile LAS unsigned* st; };
__device__ __forceinline__ XcdBarrier xcd_barrier_post(unsigned* bar, volatile LAS unsigned* st) {
    XcdBarrier b; b.bar = bar; b.x = xb_xcc_id(); b.st = st;
    if (threadIdx.x == 0) (void)xb_add(&bar[XB_XCNT(b.x)], 1u);
    return b;
}
__device__ __forceinline__ void xcd_barrier_complete(unsigned* bar, unsigned x, unsigned& nloc, unsigned& nx) {
    const unsigned G = gridDim.x * gridDim.y * gridDim.z;
    unsigned sum, cnt, mine, sp = 0u;
    for (;;) {
        sum = 0u; cnt = 0u; mine = 0u;
#pragma unroll
        for (unsigned j = 0; j < 16; ++j) { const unsigned c = xb_ld(&bar[XB_XCNT(j)]); sum += c; cnt += (c > 0u) ? 1u : 0u; mine = (j == x) ? c : mine; }
        if (sum == G) break;
        __builtin_amdgcn_s_sleep(1);
        if ((++sp & 255u) == 0u) { if (xb_ld(&bar[XB_TMO])) break; if (sp > XB_SPIN_CAP) { atomicAdd(&bar[XB_TMO], 1u); break; } }
    }
    nloc = mine > 0u ? mine : 1u; nx = cnt > 0u ? cnt : 1u;
}
__device__ __forceinline__ void xcd_barrier(const XcdBarrier& b) {
    asm volatile("s_waitcnt vmcnt(0)" ::: "memory");
    __syncthreads();
    if (threadIdx.x == 0) {
        unsigned* bar = b.bar;
        __builtin_amdgcn_s_waitcnt(0);
        unsigned nloc = b.st[0], nx = b.st[1];
        if (nloc == 0u) { xcd_barrier_complete(bar, b.x, nloc, nx); b.st[0] = nloc; b.st[1] = nx; }
        const unsigned old = xb_add(&bar[XB_XSUB(b.x)], 1u);
        const unsigned gen = old / nloc;
        if (old + 1u == (gen + 1u) * nloc) {
            __builtin_amdgcn_fence(__ATOMIC_RELEASE, "agent");
            asm volatile("s_waitcnt vmcnt(0)" ::: "memory");
            const unsigned og = xb_add(&bar[XB_TOP], 1u);
            const unsigned tg = og / nx;
            if (og + 1u == (tg + 1u) * nx) xb_add(&bar[XB_TOPGEN], 1u);
            else XB_SPIN(xb_ld(&bar[XB_TOPGEN]) == tg, bar);
            __builtin_amdgcn_fence(__ATOMIC_ACQUIRE, "agent");
            xb_add(&bar[XB_XGEN(b.x)], 1u);
            asm volatile("s_waitcnt vmcnt(0)" ::: "memory");
        } else {
            XB_SPIN(xb_ld(&bar[XB_XGEN(b.x)]) == gen, bar);
            __builtin_amdgcn_fence(__ATOMIC_ACQUIRE, "agent");
            asm volatile("s_waitcnt vmcnt(0)" ::: "memory");
        }
    }
    __syncthreads();
}
#endif

template <int TN> DEV void p0_transpose_tile(const GAS float* W, int K, int N, GAS bf16* WT, int rmul, int radd, const GAS float* scale, LAS float* scr, int item, int tid) {
#if !defined(HOST_EMU)
    asm volatile("" : "+v"(tid));
#endif
    constexpr int Q = TN / 4, P = TN + 1; const int nblk = N / TN, kb = item / nblk, nb = item % nblk, k0 = 64 * kb, n0 = TN * nb;
    constexpr int NJ = (16 * TN + 511) / 512; f32x4 v[NJ]; float sc[NJ];
#pragma unroll
    for (int j = 0; j < NJ; ++j) { const int idx = tid + 512 * j; v[j] = (f32x4){0.f, 0.f, 0.f, 0.f}; sc[j] = 1.0f;
        if (idx < 16 * TN) { const int kk = idx / Q, n4 = idx % Q; v[j] = NT_LD((const GAS f32x4*)(W + (size_t)(k0 + kk) * N + n0 + 4 * n4)); if (scale) sc[j] = scale[k0 + kk]; } }
#pragma unroll
    for (int j = 0; j < NJ; ++j) { const int idx = tid + 512 * j;
        if (idx < 16 * TN) { const int kk = idx / Q, n4 = idx % Q; const f32x4 x = v[j] * sc[j];
#pragma unroll
            for (int e_ = 0; e_ < 4; ++e_) scr[kk * P + 4 * n4 + e_] = x[e_]; } }
    __syncthreads();
#pragma unroll
    for (int j = 0; j < (8 * TN + 511) / 512; ++j) { const int pc = tid + 512 * j;
        if (pc < 8 * TN) { const int n = pc >> 3, c = pc & 7; const LAS float* s = scr + (8 * c) * P + n;
            u32x4 o; o.x = pk2(s[0 * P], s[1 * P]); o.y = pk2(s[2 * P], s[3 * P]); o.z = pk2(s[4 * P], s[5 * P]); o.w = pk2(s[6 * P], s[7 * P]);
            *(GAS u32x4*)(WT + (size_t)(rmul * (n0 + n) + radd) * K + k0 + 8 * c) = o; } }
    __syncthreads();
}
DEV void p0_row(const GAS float* xrow, GAS bf16* orow, GAS float* part, int npart, int lane) {
    const GAS f32x4* xr = (const GAS f32x4*)xrow + lane; float s = 0.f;
#pragma unroll
    for (int j = 0; j < 4; ++j) { const f32x4 v = NT_LD(xr + 64 * j); s += (v[0] * v[0] + v[1] * v[1]) + (v[2] * v[2] + v[3] * v[3]); ((GAS u32x2*)orow)[lane + 64 * j] = pk4(v); }
    s = wave_sum(s);
    if (lane < npart) part[lane] = (lane == 0) ? s : 0.f;
}
DEV void phase_prologue(const Ctx& C) {
    LAS float* scr = (LAS float*)C.lds;
    const int gw = C.bid * NWAVES + C.wave, NGW = C.G * NWAVES, lane = C.lane;
    constexpr int I_IN = (D / 64) * (IN_PROJ / 288), I_OUT = (D / 64) * (D / 256), I_G = (D / 64) * (FF / 256), I_DN = (FF / 64) * (D / 256), I_L = I_IN + I_OUT + 2 * I_G + I_DN;
    static_assert(IN_PROJ % 288 == 0 && FF % 256 == 0 && D % 256 == 0, "transpose tile widths");
    for (int it = C.bid; it < DEPTH * I_L; it += C.G) {
        const int l = it / I_L; int r = it % I_L;
        if (r < I_IN) { p0_transpose_tile<288>(GIN(I_WIN) + (size_t)l * D * IN_PROJ, D, IN_PROJ, WSP(bf16, WS_WIN) + (size_t)l * INP * D, 1, 0, GIN(I_ANORM) + l * D, scr, r, C.tid); continue; } r -= I_IN;
        if (r < I_OUT) { p0_transpose_tile<256>(GIN(I_WOUT) + (size_t)l * D * D, D, D, WSP(bf16, WS_WOUT) + (size_t)l * D * D, 1, 0, nullptr, scr, r, C.tid); continue; } r -= I_OUT;
        if (r < I_G) { p0_transpose_tile<256>(GIN(I_WGATE) + (size_t)l * D * FF, D, FF, WSP(bf16, WS_WGU) + (size_t)l * GU * D, 2, 0, GIN(I_FNORM) + l * D, scr, r, C.tid); continue; } r -= I_G;
        if (r < I_G) { p0_transpose_tile<256>(GIN(I_WUP) + (size_t)l * D * FF, D, FF, WSP(bf16, WS_WGU) + (size_t)l * GU * D, 2, 1, GIN(I_FNORM) + l * D, scr, r, C.tid); continue; } r -= I_G;
        p0_transpose_tile<256>(GIN(I_WDOWN) + (size_t)l * FF * D, FF, D, WSP(bf16, WS_WDN) + (size_t)l * D * FF, 1, 0, nullptr, scr, r, C.tid);
    }
    const int gt = C.bid * 512 + C.tid, NT = C.G * 512;
    constexpr int PADV = (INP - IN_PROJ) * D / 8;
    for (int i = gt; i < DEPTH * PADV; i += NT) { const int l = i / PADV, r = i % PADV;
        ((GAS u32x4*)(WSP(bf16, WS_WIN) + (size_t)l * INP * D + (size_t)IN_PROJ * D))[r] = (u32x4){0u, 0u, 0u, 0u}; }
    for (int i = gt; i < DEPTH * 512 * 64; i += NT) { const int l = i / (512 * 64), r = i % (512 * 64), n = r / 64, k = r % 64;
        WSP(bf16, WS_WLD)[i] = (bf16)f2bf(GIN(I_WDEC)[(size_t)l * 64 * 512 + k * 512 + n]); WSP(bf16, WS_WLA)[i] = (bf16)f2bf(GIN(I_WA)[(size_t)l * 64 * 512 + k * 512 + n]); }
    for (int i = gt; i < DEPTH * 512 * 160; i += NT) { const int l = i / (512 * 160), r = i % (512 * 160), n = r / 160, k = r % 160;
        WSP(bf16, WS_WLG)[i] = (bf16)f2bf(GIN(I_WG)[(size_t)l * 160 * 512 + k * 512 + n]); }
    for (int i = gt; i < (SEQ + 1) * 32; i += NT) { const int p = i / 32, f = i % 32; const int pos = (p == SEQ) ? PAST_LEN : p;
        const float inv = exp2f(-(float)f * (13.287712379549449f / 32.0f)); const float ang = (float)pos * inv;
        WSP(float, WS_ROPE)[p * 64 + f] = cosf(ang); WSP(float, WS_ROPE)[p * 64 + 32 + f] = sinf(ang); }
    for (int m = gw; m < MR; m += NGW) { const GAS float* xr = (m < MP) ? GIN(I_XP) + (size_t)m * D : GIN(I_XS) + (size_t)(m - MP) * D;
        if (m < MP) p0_row(xr, WSP(bf16, WS_XB) + (size_t)m * D, WSP(float, WS_PART) + (size_t)m * 16, 16, lane);
        else p0_row(xr, WSP(bf16, WS_XB) + (size_t)m * D, WSP(float, WS_PARTS) + (size_t)(m - MP) * 32, 32, lane); }
}

constexpr int PB = 144, AR = 64 * PB;
constexpr int O_RT = 0, O_AT = AR, O_BH = 2 * AR, O_KH = 3 * AR, O_ATT = 4 * AR, O_VT = 5 * AR, O_BTT = 6 * AR, O_KTT = 7 * AR;
constexpr int PG = 336, O_LW = 0, O_LA = AR, O_WD = 2 * AR, O_WA = 3 * AR, O_LG = 4 * AR, O_WG = O_LG + 64 * PG;
constexpr int O_Y = 81920, O_WPRE = O_Y, O_APRE = O_Y + 16384, O_AAB = O_Y, O_AAK = O_Y + AR, O_ARB = O_Y + 2 * AR, O_ARK = O_Y + 3 * AR;
constexpr int O_ZT = O_BH, O_DB = O_Y + 4 * AR, O_CS = O_DB + 2048, R2_END = O_CS + 2048;
static_assert(O_WG + 64 * PG <= O_Y && R2_END <= 131072, "R2 LDS map");
DEV bf16x8 ldfrag(const LAS unsigned char* base, int row, int ks, int fq) { return *(const LAS bf16x8*)(base + row * PB + (32 * ks + 8 * fq) * 2); }
DEV bf16x8 ldfragG(const LAS unsigned char* base, int row, int ks, int fq) { return *(const LAS bf16x8*)(base + row * PG + (32 * ks + 8 * fq) * 2); }
DEV int tsw(int row, int tok) { return row * PB + ((((tok >> 3) ^ (row >> 3)) & 7) << 4) + ((tok & 7) << 1); }
DEV bf16x8 ldfragS(const LAS unsigned char* base, int row, int ks, int fq, bool swz) { return *(const LAS bf16x8*)(base + row * PB + ((((4 * ks + fq) ^ (swz ? (row >> 3) : 0)) & 7) << 4)); }
DEV u32x2 ld4(const LAS unsigned char* base, int row, int col) { return *(const LAS u32x2*)(base + row * PB + col * 2); }
DEV void st4(LAS unsigned char* base, int row, int col, u32x2 v) { *(LAS u32x2*)(base + row * PB + col * 2) = v; }
DEV void st1(LAS unsigned char* base, int row, int col, float v) { *(LAS bf16*)(base + row * PB + col * 2) = (bf16)f2bf(v); }

DEV void rwkv_prep_item(const Ctx& C, int l, int item, u32x4 (&lc)[5], bool first) {
#if !defined(HOST_EMU)
    asm volatile("" : "+v"(item));
#endif
    const int h = item & 7, c = (item >> 3) % NCH, b = (item >> 3) / NCH;
    int tid = C.tid;
#if !defined(HOST_EMU)
    asm volatile("" : "+v"(tid));
#endif
    const int lane = tid & 63, w = __builtin_amdgcn_readfirstlane(tid >> 6), fr = lane & 15, fq = lane >> 4;
    LAS unsigned char* L = C.lds;
    const GAS bf16* proj = WSP(bf16, WS_PROJ); const int row0 = b * SEQ + 64 * c;
    const GAS float* mu = GIN(I_MU) + (size_t)l * A_PROJ;
    const int t = tid >> 3, cg = tid & 7;
    float r_[8], k_[8], v_[8];
#ifdef REPMASK
    for (int rep_ = 0; rep_ < ((REPMASK >> 0) & 1) + 1; ++rep_) { asm volatile("" ::: "memory");
#else
    {
#endif
    {
        struct Raw8 { u32x4 a, p; f32x4 m0, m1; };
#define XS8_LD(R, rowi, hpv, col) do { const GAS bf16* pr_ = proj + (size_t)(rowi) * IN_PROJ + (col); R.a = *(const GAS u32x4*)pr_; R.p = (u32x4){0u, 0u, 0u, 0u}; if (hpv) R.p = *(const GAS u32x4*)(pr_ - IN_PROJ); \
            R.m0 = *(const GAS f32x4*)(mu + (col)); R.m1 = *(const GAS f32x4*)(mu + (col) + 4); } while (0)
#define XS8_CV(dst, R) do { _Pragma("unroll") for (int j_ = 0; j_ < 4; ++j_) { const f32x2 a_ = {bf2f(R.a[j_]), bf2f(R.a[j_] >> 16)}, p_ = {bf2f(R.p[j_]), bf2f(R.p[j_] >> 16)}; \
            const f32x2 m_ = (j_ < 2) ? (f32x2){R.m0[2 * j_], R.m0[2 * j_ + 1]} : (f32x2){R.m1[2 * j_ - 4], R.m1[2 * j_ - 3]}; const f32x2 x_ = a_ + m_ * (p_ - a_); dst[2 * j_] = x_.x; dst[2 * j_ + 1] = x_.y; } } while (0)
        const bool hp = (64 * c + t) > 0;
        Raw8 rr, rk, rv, rl[5];
        XS8_LD(rr, row0 + t, hp, h * 64 + 8 * cg); XS8_LD(rk, row0 + t, hp, 512 + h * 64 + 8 * cg); XS8_LD(rv, row0 + t, hp, 1024 + h * 64 + 8 * cg);
        if (first) {
#pragma unroll
            for (int j = 0; j < 5; ++j) { const int idx = tid + 512 * j; if (idx < 64 * 36) { const int tt = idx / 36, ch = idx % 36; XS8_LD(rl[j], row0 + tt, (64 * c + tt) > 0, 1536 + 8 * ch); } } }
        const u32x4 wdv = *(const GAS u32x4*)(WSP(bf16, WS_WLD) + ((size_t)l * 512 + h * 64 + (tid >> 3)) * 64 + (tid & 7) * 8), wav = *(const GAS u32x4*)(WSP(bf16, WS_WLA) + ((size_t)l * 512 + h * 64 + (tid >> 3)) * 64 + (tid & 7) * 8);
        u32x4 wgv[3];
#pragma unroll
        for (int j = 0; j < 3; ++j) { const int idx = tid + 512 * j; if (idx < 64 * 20) wgv[j] = *(const GAS u32x4*)(WSP(bf16, WS_WLG) + ((size_t)l * 512 + h * 64 + idx / 20) * 160 + (idx % 20) * 8); }
        XS8_CV(r_, rr); XS8_CV(k_, rk); XS8_CV(v_, rv);
        if (first) {
#pragma unroll
            for (int j = 0; j < 5; ++j) { const int idx = tid + 512 * j;
                if (idx < 64 * 36) { const int ch = idx % 36; float x[8]; XS8_CV(x, rl[j]);
                    if (ch < 8) {
#pragma unroll
                        for (int e = 0; e < 8; ++e) x[e] = tanhf_(x[e]); }
                    else if (ch >= 16) {
#pragma unroll
                        for (int e = 0; e < 8; ++e) x[e] = sigmoidf_(x[e]); }
                    u32x4 o; o.x = pk2(x[0], x[1]); o.y = pk2(x[2], x[3]); o.z = pk2(x[4], x[5]); o.w = pk2(x[6], x[7]); lc[j] = o; } } }
#pragma unroll
        for (int j = 0; j < 5; ++j) { const int idx = tid + 512 * j;
            if (idx < 64 * 36) { const int tt = idx / 36, ch = idx % 36;
                LAS unsigned char* dst = (ch < 8) ? L + O_LW + tt * PB + ch * 16 : (ch < 16) ? L + O_LA + tt * PB + (ch - 8) * 16 : L + O_LG + tt * PG + (ch - 16) * 16;
                *(LAS u32x4*)dst = lc[j]; } }
#undef XS8_LD
#undef XS8_CV
        *(LAS u32x4*)(L + O_WD + (tid >> 3) * PB + (tid & 7) * 16) = wdv; *(LAS u32x4*)(L + O_WA + (tid >> 3) * PB + (tid & 7) * 16) = wav;
#pragma unroll
        for (int j = 0; j < 3; ++j) { const int idx = tid + 512 * j; if (idx < 64 * 20) *(LAS u32x4*)(L + O_WG + (idx / 20) * PG + (idx % 20) * 16) = wgv[j]; }
    }
    }
    __syncthreads();
#ifdef REPMASK
    for (int rep_ = 0; rep_ < ((REPMASK >> 1) & 1) + 1; ++rep_) { asm volatile("" ::: "memory");
#else
    {
#endif
#pragma unroll
    for (int q = 0; q < 2; ++q) { const int id = 2 * w + q, mt = id >> 2, nt = id & 3;
        f32x4 aw = {0.f, 0.f, 0.f, 0.f}, aa = {0.f, 0.f, 0.f, 0.f}, ag = {0.f, 0.f, 0.f, 0.f};
#pragma unroll
        for (int ks = 0; ks < 2; ++ks) { aw = MFMA16(ldfrag(L + O_WD, 16 * mt + fr, ks, fq), ldfrag(L + O_LW, 16 * nt + fr, ks, fq), aw);
                                         aa = MFMA16(ldfrag(L + O_WA, 16 * mt + fr, ks, fq), ldfrag(L + O_LA, 16 * nt + fr, ks, fq), aa); }
#pragma unroll
        for (int ks = 0; ks < 5; ++ks) ag = MFMA16(ldfragG(L + O_WG, 16 * mt + fr, ks, fq), ldfragG(L + O_LG, 16 * nt + fr, ks, fq), ag);
        const int tok = 16 * nt + fr, ch0 = 16 * mt + 4 * fq;
        *(LAS f32x4*)(L + O_WPRE + (tok * 64 + ch0) * 4) = aw; *(LAS f32x4*)(L + O_APRE + (tok * 64 + ch0) * 4) = aa;
        *(GAS u32x2*)(WSP(bf16, WS_G) + (size_t)(row0 + tok) * 512 + h * 64 + ch0) = pk4(ag); }
    }
    __syncthreads();
    float ld_[8], g_[8], av_[8], bv_[8], km_[8];
#ifdef REPMASK
    for (int rep_ = 0; rep_ < ((REPMASK >> 2) & 1) + 1; ++rep_) { asm volatile("" ::: "memory");
#else
    {
#endif
    {
        const int cc = l * 512 + h * 64 + 8 * cg; float wp[8], ap[8], w0v[8], a0v[8], kkv[8], kav[8], rkv[8];
#define LD8G(dst, ptr) do { const f32x4 a_ = *(const GAS f32x4*)(ptr), b_ = *(const GAS f32x4*)((ptr) + 4); _Pragma("unroll") for (int e_ = 0; e_ < 4; ++e_) { dst[e_] = a_[e_]; dst[4 + e_] = b_[e_]; } } while (0)
#define LD8L(dst, off) do { const f32x4 a_ = *(const LAS f32x4*)(L + (off)), b_ = *(const LAS f32x4*)(L + (off) + 16); _Pragma("unroll") for (int e_ = 0; e_ < 4; ++e_) { dst[e_] = a_[e_]; dst[4 + e_] = b_[e_]; } } while (0)
        LD8L(wp, O_WPRE + (t * 64 + 8 * cg) * 4); LD8L(ap, O_APRE + (t * 64 + 8 * cg) * 4);
        LD8G(w0v, GIN(I_W0) + cc); LD8G(a0v, GIN(I_A0) + cc); LD8G(kkv, GIN(I_KK) + cc); LD8G(kav, GIN(I_KA) + cc); LD8G(rkv, GIN(I_RK) + cc);
        float ssq = 0.f, rks = 0.f, as_[8], kk_[8];
#pragma unroll
        for (int e = 0; e < 8; ++e) { const float wl = -softplusf_(-(wp[e] + w0v[e])) - 0.5f; ld_[e] = -fexp(wl); as_[e] = sigmoidf_(a0v[e] + ap[e]);
            kk_[e] = k_[e] * kkv[e]; ssq += kk_[e] * kk_[e]; km_[e] = k_[e] * (1.0f + (as_[e] - 1.0f) * kav[e]); rks += r_[e] * km_[e] * rkv[e]; }
        ssq += SHFLX(ssq, 1); ssq += SHFLX(ssq, 2); ssq += SHFLX(ssq, 4); rks += SHFLX(rks, 1); rks += SHFLX(rks, 2); rks += SHFLX(rks, 4);
        const float inv = frsq(fmaxf(ssq, 1e-24f));
        if (cg == 0) WSP(float, WS_RKR)[(size_t)(row0 + t) * 8 + h] = rks;
#pragma unroll
        for (int e = 0; e < 8; ++e) { const float kkn = kk_[e] * inv; av_[e] = -kkn; bv_[e] = kkn * as_[e]; g_[e] = ld_[e]; }
#pragma unroll
        for (int off = 8; off < 64; off <<= 1) {
#pragma unroll
            for (int e = 0; e < 8; ++e) { const float o_ = SHFL(g_[e], (lane - off) & 63); if (lane >= off) g_[e] += o_; } }
        if (lane >= 56) {
#pragma unroll
            for (int e = 0; e < 8; ++e) *(LAS float*)(L + O_CS + (w * 64 + 8 * cg + e) * 4) = g_[e]; }
    }
    __syncthreads();
    {
        float off[8], g63[8];
#pragma unroll
        for (int e = 0; e < 8; ++e) { off[e] = 0.f; g63[e] = 0.f; }
#pragma unroll
        for (int ww = 0; ww < 8; ++ww) { float v8[8]; LD8L(v8, O_CS + (ww * 64 + 8 * cg) * 4);
#pragma unroll
            for (int e = 0; e < 8; ++e) { g63[e] += v8[e]; if (ww < w) off[e] += v8[e]; } }
        if (tid < 8) {
#pragma unroll
            for (int e = 0; e < 8; ++e) WSP(float, WS_CHG)[(size_t)item * 64 + 8 * cg + e] = fexp(g63[e]); }
        float rt[8], at[8], bh[8], kh[8];
#pragma unroll
        for (int e = 0; e < 8; ++e) { const float g = off[e] + g_[e]; const float eg = fexp(g), egx = fexp(g - ld_[e]), eng = fexp(-g), e63 = fexp(g63[e] - g);
            rt[e] = r_[e] * eg; at[e] = av_[e] * egx; bh[e] = bv_[e] * eng; kh[e] = km_[e] * eng;
            { const int o_ = tsw(8 * cg + e, t);
              const unsigned w1_ = pk2(at[e], v_[e]), w2_ = pk2(bv_[e] * e63, km_[e] * e63);
              *(LAS bf16*)(L + O_ATT + o_) = (bf16)w1_; *(LAS bf16*)(L + O_VT + o_) = (bf16)(w1_ >> 16); *(LAS bf16*)(L + O_BTT + o_) = (bf16)w2_; *(LAS bf16*)(L + O_KTT + o_) = (bf16)(w2_ >> 16); } }
#define ST8(off_, a_) do { u32x4 o_; o_.x = pk2(a_[0], a_[1]); o_.y = pk2(a_[2], a_[3]); o_.z = pk2(a_[4], a_[5]); o_.w = pk2(a_[6], a_[7]); *(LAS u32x4*)(L + (off_) + t * PB + cg * 16) = o_; } while (0)
        ST8(O_RT, rt); ST8(O_AT, at); ST8(O_BH, bh); ST8(O_KH, kh);
#undef ST8
#undef LD8G
#undef LD8L
        if (c == NCH - 1 && h == 0) for (int col = tid; col < A_PROJ; col += 512) GOUT[O_PSH + (size_t)(l * BATCH + b) * A_PROJ + col] = bf2f(proj[(size_t)(b * SEQ + SEQ - 1) * IN_PROJ + col]);
    }
    __syncthreads();
    }
#ifdef REPMASK
    for (int rep_ = 0; rep_ < ((REPMASK >> 3) & 1) + 1; ++rep_) { asm volatile("" ::: "memory");
#else
    {
#endif
    {
        const int p = w >> 1, mtb = 2 * (w & 1); const LAS unsigned char* X = L + ((p < 2) ? O_AT : O_RT); const LAS unsigned char* Y = L + ((p & 1) ? O_KH : O_BH);
        bf16x8 ya[2][2], xb_[4][2];
#pragma unroll
        for (int ks = 0; ks < 2; ++ks) {
#pragma unroll
            for (int i = 0; i < 2; ++i) ya[i][ks] = ldfrag(Y, 16 * (mtb + i) + fr, ks, fq);
#pragma unroll
            for (int nt = 0; nt < 4; ++nt) xb_[nt][ks] = ldfrag(X, 16 * nt + fr, ks, fq); }
#pragma unroll
        for (int i = 0; i < 2; ++i)
#pragma unroll
            for (int nt = 0; nt < 4; ++nt) { const int mt = mtb + i; f32x4 acc = {0.f, 0.f, 0.f, 0.f};
                if (mt <= nt) { acc = MFMA16(ya[i][0], xb_[nt][0], acc); acc = MFMA16(ya[i][1], xb_[nt][1], acc);
                    if (mt == nt) { const int dlt = fr - 4 * fq - ((p < 2) ? 1 : 0);
#pragma unroll
                        for (int e = 0; e < 4; ++e) if (e > dlt) acc[e] = 0.f; } }
                st4(L + O_AAB + p * AR, 16 * nt + fr, 16 * mt + 4 * fq, pk4(acc)); }
    }
    }
    __syncthreads();
#ifdef REPMASK
    for (int rep_ = 0; rep_ < ((REPMASK >> 4) & 1) + 1; ++rep_) { asm volatile("" ::: "memory");
#else
    {
#endif
#pragma unroll
    for (int q = 0; q < 2; ++q) { const int id = 2 * w + q, mt = id >> 2, nt = id & 3; f32x4 acc = {0.f, 0.f, 0.f, 0.f};
#pragma unroll
        for (int ks = 0; ks < 2; ++ks) acc = MFMA16(ldfrag(L + O_AAK, 16 * mt + fr, ks, fq), ldfragS(L + O_VT, 16 * nt + fr, ks, fq, true), acc);
        *(LAS u32x2*)(L + O_ZT + tsw(16 * nt + fr, 16 * mt + 4 * fq)) = pk4(acc); }
    if (w == 7) { const int blk = lane >> 4, cc = lane & 15; float T_[16];
#pragma unroll
        for (int t = 0; t < 16; ++t) { float a = (t == cc) ? 1.0f : 0.0f;
#pragma unroll
            for (int s = 0; s < t; ++s) a += bf2f(*(const LAS bf16*)(L + O_AAB + (16 * blk + t) * PB + (16 * blk + s) * 2)) * T_[s];
            T_[t] = a; *(LAS bf16*)(L + O_DB + blk * 512 + t * 32 + cc * 2) = (bf16)f2bf(a); } }
    }
    __syncthreads();
    {
        LAS unsigned char* arr = L + ((w < 4) ? O_ATT : O_ZT); const int srow = 16 * (w & 3) + fr;
        const u32x2 z2 = {0u, 0u}; f32x4 X[4];
#pragma unroll
        for (int i = 0; i < 4; ++i) {
            f32x4 inner = up4(*(const LAS u32x2*)(arr + tsw(srow, 16 * i + 4 * fq)));
#pragma unroll
            for (int kk = 0; kk < i; kk += 2) {
                const u32x2 blo = pk4(X[kk]), bhi = (kk + 1 < i) ? pk4(X[kk + 1]) : z2;
                const u32x2 alo = ld4(L + O_AAB, 16 * i + fr, 16 * kk + 4 * fq), ahi = (kk + 1 < i) ? ld4(L + O_AAB, 16 * i + fr, 16 * (kk + 1) + 4 * fq) : z2;
                inner = MFMA16(mk8(alo, ahi), mk8(blo, bhi), inner); }
            const u32x2 dlo = *(const LAS u32x2*)(L + O_DB + i * 512 + fr * 32 + 4 * fq * 2);
            X[i] = MFMA16(mk8(dlo, z2), mk8(pk4(inner), z2), ((f32x4){0.f, 0.f, 0.f, 0.f}));
            *(LAS u32x2*)(arr + tsw(srow, 16 * i + 4 * fq)) = pk4(X[i]); }
    }
    __syncthreads();
#ifdef REPMASK
    for (int rep_ = 0; rep_ < ((REPMASK >> 6) & 1) + 1; ++rep_) { asm volatile("" ::: "memory");
#else
    {
#endif
    {
        const int p = w >> 1, mtb = 2 * (w & 1); const bool two = (p & 1) != 0;
        const int oa1 = (p == 0 || p == 2) ? O_ATT : (p == 1 ? O_ZT : O_BTT), ob1 = (p <= 1) ? O_ARB : (p == 2 ? O_BTT : O_ZT), oa2 = (p == 1) ? O_VT : O_KTT, ob2 = (p == 1) ? O_ARK : O_VT;
        bf16x8 a1[2][2], b1[4][2], a2[2][2], b2[4][2];
#pragma unroll
        for (int ks = 0; ks < 2; ++ks) {
#pragma unroll
            for (int i = 0; i < 2; ++i) { a1[i][ks] = ldfragS(L + oa1, 16 * (mtb + i) + fr, ks, fq, true); a2[i][ks] = a1[i][ks]; if (two) a2[i][ks] = ldfragS(L + oa2, 16 * (mtb + i) + fr, ks, fq, true); }
#pragma unroll
            for (int nt = 0; nt < 4; ++nt) { b1[nt][ks] = ldfragS(L + ob1, 16 * nt + fr, ks, fq, p >= 2); b2[nt][ks] = b1[nt][ks]; if (two) b2[nt][ks] = ldfragS(L + ob2, 16 * nt + fr, ks, fq, p >= 2); } }
#pragma unroll
        for (int i = 0; i < 2; ++i)
#pragma unroll
            for (int nt = 0; nt < 4; ++nt) { const int r0 = 16 * (mtb + i) + 4 * fq, cn = 16 * nt + fr; f32x4 acc = {0.f, 0.f, 0.f, 0.f};
                if (p == 0) acc = up4(ld4(L + O_RT, cn, r0));
                acc = MFMA16(a1[i][0], b1[nt][0], acc); acc = MFMA16(a1[i][1], b1[nt][1], acc);
                if (two) { acc = MFMA16(a2[i][0], b2[nt][0], acc); acc = MFMA16(a2[i][1], b2[nt][1], acc); }
                const size_t o = (size_t)item * 4096 + cn * 64 + r0;
                *(GAS u32x2*)((p == 0 ? WSP(bf16, WS_CHP) : p == 1 ? WSP(bf16, WS_CHW) : p == 2 ? WSP(bf16, WS_CHM) : WSP(bf16, WS_CHN)) + o) = pk4(acc); }
    }
    }
    __syncthreads();
}

constexpr int SM_XS = 0, SM_QKV = 7424, SM_TW = 10496, SM_SG = 10752, SM_VR = 11520, SM_VW = SM_VR + 2048, SM_VK = SM_VW + 2048, SM_VA = SM_VK + 2048, SM_VB = SM_VA + 2048,
              SM_QR = SM_VB + 2048, SM_KN = SM_QR + 2048, SM_PL = SM_KN + 512, SM_END = SM_PL + 4096,
              SM_KC = 32768, SM_KCP = 68  , SM_KC_END = SM_KC + 2 * 127 * SM_KCP * 4;
static_assert(SM_END <= SM_KC && SM_KC_END <= 131072, "sample mixer LDS map");
DEV void sample_mix_item(const Ctx& C, int l, int sb, int part) {
#if !defined(HOST_EMU)
    asm volatile("" : "+v"(sb));
#endif
    int tid = C.tid;
#if !defined(HOST_EMU)
    asm volatile("" : "+v"(tid));
#endif
    const int lane = tid & 63, w = tid >> 6; LAS unsigned char* L = C.lds;
    LAS float* XSv = (LAS float*)(L + SM_XS); LAS float* QKV = (LAS float*)(L + SM_QKV); LAS float* TW = (LAS float*)(L + SM_TW); LAS float* SG = (LAS float*)(L + SM_SG);
    LAS float* VR = (LAS float*)(L + SM_VR); LAS float* VW = (LAS float*)(L + SM_VW); LAS float* VK = (LAS float*)(L + SM_VK); LAS float* VA = (LAS float*)(L + SM_VA); LAS float* VB = (LAS float*)(L + SM_VB);
    LAS float* QR = (LAS float*)(L + SM_QR); LAS float* KN = (LAS float*)(L + SM_KN); LAS float* PL = (LAS float*)(L + SM_PL);
    const int row = MP + sb; const GAS bf16* pr = WSP(bf16, WS_PROJ) + (size_t)row * IN_PROJ; const size_t ls = (size_t)l * MS + sb;
    const GAS float* mu = GIN(I_MU) + (size_t)l * A_PROJ;
    f32x4 vv[16];
    if (part == 0) {
        float pa[4], pv[4], mv[4];
#pragma unroll
        for (int j = 0; j < 4; ++j) { const int col = tid + 512 * j; pa[j] = 0.f; pv[j] = 0.f; mv[j] = 0.f; if (col < A_PROJ) { pa[j] = bf2f(pr[col]); pv[j] = GIN(I_SSHIFT)[ls * A_PROJ + col]; mv[j] = mu[col]; } }
#pragma unroll
        for (int j = 0; j < 4; ++j) { const int col = tid + 512 * j; if (col < A_PROJ) { XSv[col] = pa[j] + mv[j] * (pv[j] - pa[j]); GOUT[O_SSH + ls * A_PROJ + col] = pa[j]; } }
    } else {
        const GAS f32x4* kc = (const GAS f32x4*)(GIN(I_CK) + (ls * 128 + 1) * 128); f32x4 kb[8];
#pragma unroll
        for (int j = 0; j < 8; ++j) { const int idx = tid + 512 * j; kb[j] = (f32x4){0.f, 0.f, 0.f, 0.f}; if (idx < 127 * 32) kb[j] = kc[idx]; }
        { const int kg = lane >> 4, dq = lane & 15; const GAS float* vp = GIN(I_CV) + (ls * 128 + 1) * 128 + (w >> 2) * 64 + 4 * dq;
#pragma unroll
          for (int j = 0; j < 16; ++j) { const int u = kg + 4 * j; vv[j] = *(const GAS f32x4*)(vp + (size_t)u * 128); } }
        float pa[2];
#pragma unroll
        for (int j = 0; j < 2; ++j) { const int col = tid + 512 * j; pa[j] = 0.f; if (col < IN_PROJ - A_PROJ) pa[j] = bf2f(pr[A_PROJ + col]); }
#pragma unroll
        for (int j = 0; j < 2; ++j) { const int col = tid + 512 * j; if (col < IN_PROJ - A_PROJ) QKV[col] = pa[j]; }
#pragma unroll
        for (int j = 0; j < 8; ++j) { const int idx = tid + 512 * j, krow = idx >> 5, c = idx & 31; if (idx < 127 * 32) *(LAS f32x4*)(L + SM_KC + (((c >> 4) * 127 + krow) * SM_KCP + 4 * (c & 15)) * 4) = kb[j]; }
    }
    __syncthreads();
    if (part == 0) {
    if (tid < 64) TW[tid] = tanhf_(XSv[1536 + tid]); else if (tid < 224) SG[tid - 64] = sigmoidf_(XSv[1664 + tid - 64]);
    __syncthreads();
    const int ch = tid, cl = l * 512 + ch;
    float wp = GIN(I_W0)[cl], ap = GIN(I_A0)[cl], gg = 0.f;
    {
      const GAS u32x4* Wd = (const GAS u32x4*)(WSP(bf16, WS_WLD) + ((size_t)l * 512 + ch) * 64); const GAS u32x4* Wa = (const GAS u32x4*)(WSP(bf16, WS_WLA) + ((size_t)l * 512 + ch) * 64);
      const GAS u32x4* Wg = (const GAS u32x4*)(WSP(bf16, WS_WLG) + ((size_t)l * 512 + ch) * 160);
      u32x4 wd[8], wa[8], wg[20];
#pragma unroll
      for (int q = 0; q < 8; ++q) { wd[q] = Wd[q]; wa[q] = Wa[q]; }
#pragma unroll
      for (int q = 0; q < 20; ++q) wg[q] = Wg[q];
#pragma unroll
      for (int q = 0; q < 8; ++q) { const f32x4 t0 = *(const LAS f32x4*)(TW + 8 * q), t1 = *(const LAS f32x4*)(TW + 8 * q + 4), x0 = *(const LAS f32x4*)(XSv + 1600 + 8 * q), x1 = *(const LAS f32x4*)(XSv + 1600 + 8 * q + 4);
          const f32x4 d0 = up4((u32x2){wd[q].x, wd[q].y}), d1 = up4((u32x2){wd[q].z, wd[q].w}), a0 = up4((u32x2){wa[q].x, wa[q].y}), a1 = up4((u32x2){wa[q].z, wa[q].w});
          wp += (t0[0] * d0[0] + t0[1] * d0[1]) + (t0[2] * d0[2] + t0[3] * d0[3]) + (t1[0] * d1[0] + t1[1] * d1[1]) + (t1[2] * d1[2] + t1[3] * d1[3]);
          ap += (x0[0] * a0[0] + x0[1] * a0[1]) + (x0[2] * a0[2] + x0[3] * a0[3]) + (x1[0] * a1[0] + x1[1] * a1[1]) + (x1[2] * a1[2] + x1[3] * a1[3]); }
#pragma unroll
      for (int q = 0; q < 20; ++q) { const f32x4 s0 = *(const LAS f32x4*)(SG + 8 * q), s1 = *(const LAS f32x4*)(SG + 8 * q + 4);
          const f32x4 g0 = up4((u32x2){wg[q].x, wg[q].y}), g1 = up4((u32x2){wg[q].z, wg[q].w});
          gg += (s0[0] * g0[0] + s0[1] * g0[1]) + (s0[2] * g0[2] + s0[3] * g0[3]) + (s1[0] * g1[0] + s1[1] * g1[1]) + (s1[2] * g1[2] + s1[3] * g1[3]); } }
    f32x4 t[16];
    { const GAS f32x4* sg0 = (const GAS f32x4*)(GIN(I_SRWKV) + (ls * 8 + w) * 4096);
#pragma unroll
      for (int j = 0; j < 16; ++j) { const int idx = lane + 64 * (j & 7); t[j] = sg0[(idx >> 3) * 16 + 8 * (j >> 3) + (idx & 7)]; } }
    const float wl = -softplusf_(-wp) - 0.5f, dec = fexp(-fexp(wl)), as = sigmoidf_(ap);
    const float r = XSv[ch], k = XSv[512 + ch], v = XSv[1024 + ch];
    const float kk = k * GIN(I_KK)[cl]; const float kkn = kk * frsq(fmaxf(wave_sum(kk * kk), 1e-24f));
    const float km = k * (1.0f + (as - 1.0f) * GIN(I_KA)[cl]); const float rkr = wave_sum(r * km * GIN(I_RK)[cl]);
    VR[ch] = r; VW[ch] = dec; VK[ch] = km; VA[ch] = -kkn; VB[ch] = kkn * as;
    __syncthreads();
    {
        const size_t hb = (ls * 8 + w) * 4096; LAS float* SL = (LAS float*)(L + SM_KC + w * (64 * 36 * 4)); f32x4 S[16];
        {
#pragma unroll
          for (int h2 = 0; h2 < 2; ++h2) {
#pragma unroll
              for (int j = 0; j < 8; ++j) { const int idx = lane + 64 * j; *(LAS f32x4*)(SL + (idx >> 3) * 36 + 4 * (idx & 7)) = t[8 * h2 + j]; }
              WAVE_SYNC();
#pragma unroll
              for (int j = 0; j < 8; ++j) S[8 * h2 + j] = *(const LAS f32x4*)(SL + lane * 36 + 4 * j);
              WAVE_SYNC(); } }
        float sa = 0.f;
#pragma unroll
        for (int j = 0; j < 16; ++j) { const f32x4 a = *(const LAS f32x4*)(VA + 64 * w + 4 * j); sa += (S[j][0] * a[0] + S[j][1] * a[1]) + (S[j][2] * a[2] + S[j][3] * a[3]); }
        float y = 0.f; GAS f32x4* og = (GAS f32x4*)(GOUT + O_SS + hb);
#pragma unroll
        for (int j = 0; j < 16; ++j) { const f32x4 ww = *(const LAS f32x4*)(VW + 64 * w + 4 * j), bb = *(const LAS f32x4*)(VB + 64 * w + 4 * j), kv = *(const LAS f32x4*)(VK + 64 * w + 4 * j), rr = *(const LAS f32x4*)(VR + 64 * w + 4 * j);
            const f32x4 sn = S[j] * ww + sa * bb + v * kv; S[j] = sn; y += (sn[0] * rr[0] + sn[1] * rr[1]) + (sn[2] * rr[2] + sn[3] * rr[3]); }
#pragma unroll
        for (int h2 = 0; h2 < 2; ++h2) {
#pragma unroll
            for (int j = 0; j < 8; ++j) *(LAS f32x4*)(SL + lane * 36 + 4 * j) = S[8 * h2 + j];
            WAVE_SYNC();
#pragma unroll
            for (int j = 0; j < 8; ++j) { const int idx = lane + 64 * j; NT_ST(og + (idx >> 3) * 16 + 8 * h2 + (idx & 7), *(const LAS f32x4*)(SL + (idx >> 3) * 36 + 4 * (idx & 7))); }
            WAVE_SYNC(); }
        const float mean = wave_sum(y) * (1.0f / 64.0f), dd = y - mean, var = wave_sum(dd * dd) * (1.0f / 64.0f);
        const float yn = dd * frsq(var + LNX_EPS) * GIN(I_LNG)[cl] + GIN(I_LNB)[cl];
        WSP(bf16, WS_MIX)[(size_t)row * D + ch] = (bf16)f2bf((yn + rkr * v) * gg);
    }
    } else {
    {
        const int d = lane, dd = d & 31; const float cs = WSP(float, WS_ROPE)[SEQ * 64 + dd], sn = WSP(float, WS_ROPE)[SEQ * 64 + 32 + dd];
        { const float x1 = QKV[w * 64 + dd], x2 = QKV[w * 64 + 32 + dd]; QR[w * 64 + d] = ((d < 32) ? x1 * cs - x2 * sn : x2 * cs + x1 * sn) * 0.125f; }
        if (w < 2) { const float x1 = QKV[512 + w * 64 + dd], x2 = QKV[512 + w * 64 + 32 + dd]; const float kr = (d < 32) ? x1 * cs - x2 * sn : x2 * cs + x1 * sn;
            KN[w * 64 + d] = kr; GOUT[O_SK + (ls * 128 + 127) * 128 + w * 64 + d] = kr; GOUT[O_SV + (ls * 128 + 127) * 128 + w * 64 + d] = QKV[640 + w * 64 + d]; }
    }
    __syncthreads();
    {
        const int hq = w, kvh = hq >> 2; const float sink = GIN(I_SINK)[l * 8 + hq];
        float s[2];
#pragma unroll
        for (int kx = 0; kx < 2; ++kx) { const int u = lane + 64 * kx; float a = 0.f;
            if (u < 127) { const LAS f32x4* kp = (const LAS f32x4*)(L + SM_KC + ((kvh * 127 + u) * SM_KCP) * 4);
#pragma unroll
                for (int j = 0; j < 16; ++j) { const f32x4 kq = kp[j], qq = *(const LAS f32x4*)(QR + hq * 64 + 4 * j); a += (kq[0] * qq[0] + kq[1] * qq[1]) + (kq[2] * qq[2] + kq[3] * qq[3]); } }
            else {
#pragma unroll
                for (int j = 0; j < 16; ++j) { const f32x4 kq = *(const LAS f32x4*)(KN + kvh * 64 + 4 * j), qq = *(const LAS f32x4*)(QR + hq * 64 + 4 * j); a += (kq[0] * qq[0] + kq[1] * qq[1]) + (kq[2] * qq[2] + kq[3] * qq[3]); } }
            s[kx] = a; }
        const float m = fmaxf(wave_max(fmaxf(s[0], s[1])), sink); const float p0 = fexp(s[0] - m), p1 = fexp(s[1] - m);
        const float den = wave_sum(p0 + p1) + fexp(sink - m);
        PL[hq * 128 + lane] = p0; PL[hq * 128 + 64 + lane] = p1;
        WAVE_SYNC();
        const int kg = lane >> 4, dq = lane & 15; f32x4 o = {0.f, 0.f, 0.f, 0.f}; const GAS float* vp = GIN(I_CV) + (ls * 128 + 1) * 128 + kvh * 64 + 4 * dq;
        {
            f32x4 v2[16];
#pragma unroll
            for (int j = 0; j < 16; ++j) { const int u = kg + 4 * (16 + j); v2[j] = (f32x4){0.f, 0.f, 0.f, 0.f}; if (u < 127) v2[j] = *(const GAS f32x4*)(vp + (size_t)u * 128); }
#pragma unroll
            for (int j = 0; j < 16; ++j) { const int u = kg + 4 * j; o += PL[hq * 128 + u] * vv[j]; }
#pragma unroll
            for (int j = 0; j < 16; ++j) { const int u = kg + 4 * (16 + j); o += PL[hq * 128 + (u < 127 ? u : 0)] * v2[j]; } }
        if (kg == 0) o += PL[hq * 128 + 127] * *(const LAS f32x4*)(QKV + 640 + kvh * 64 + 4 * dq);
#pragma unroll
        for (int e = 0; e < 4; ++e) { o[e] += SHFLX(o[e], 16); o[e] += SHFLX(o[e], 32); }
        if (kg == 0) *(GAS u32x2*)(WSP(bf16, WS_MIX) + (size_t)row * D + 512 + hq * 64 + 4 * dq) = pk4(o * (1.0f / den));
    }
    }
    __syncthreads();
}

DEV void cache_shift_item(const Ctx& C, int l, int it) {
    const int sb = it >> 1, kv = it & 1, tid = C.tid; const size_t ls = (size_t)l * MS + sb;
    const GAS f32x4* src = (const GAS f32x4*)((kv ? GIN(I_CV) : GIN(I_CK)) + ls * 16384 + 128); GAS f32x4* dst = (GAS f32x4*)(GOUT + (kv ? O_SV : O_SK) + ls * 16384);
    f32x4 v[8];
#pragma unroll
    for (int j = 0; j < 8; ++j) { const int i = tid + 512 * j; if (i < 127 * 32) v[j] = NT_LD(src + i); }
#pragma unroll
    for (int j = 0; j < 8; ++j) { const int i = tid + 512 * j; if (i < 127 * 32) NT_ST(dst + i, v[j]); }
}

constexpr int SC_MP = 136, SC_NP = 136, SC_M = 0, SC_N = 64 * SC_MP, SC_G = SC_N + 16 * SC_NP, SC_SLOT = SC_G + 256, SC_R = 9, SC_D = 7;
static_assert(SC_SLOT % 16 == 0 && SC_R * SC_SLOT + 128 <= 131072, "scan ring");
struct ScanLd { u32x4 m[8], n[2], g; };
DEV void scan_ld_issue(const Ctx& C, ScanLd& o, int item, int sl, int lane) {
    const GAS u32x4* M = (const GAS u32x4*)(WSP(bf16, WS_CHM) + (size_t)item * 4096); const GAS u32x4* N = (const GAS u32x4*)(WSP(bf16, WS_CHN) + (size_t)item * 4096 + sl * 1024); const GAS u32x4* G = (const GAS u32x4*)(WSP(float, WS_CHG) + (size_t)item * 64);
#pragma unroll
    for (int j = 0; j < 8; ++j) o.m[j] = M[lane + 64 * j];
#pragma unroll
    for (int j = 0; j < 2; ++j) o.n[j] = N[lane + 64 * j];
    o.g = G[lane & 15];
}
DEV void scan_ld_write(const ScanLd& o, LAS unsigned char* slot, int lane) {
#pragma unroll
    for (int j = 0; j < 8; ++j) { const int pc = lane + 64 * j, row = pc >> 3, cc = pc & 7; LAS u32x2* d = (LAS u32x2*)(slot + SC_M + row * SC_MP + cc * 16); d[0] = (u32x2){o.m[j].x, o.m[j].y}; d[1] = (u32x2){o.m[j].z, o.m[j].w}; }
#pragma unroll
    for (int j = 0; j < 2; ++j) { const int pc = lane + 64 * j, row = pc >> 3, cc = pc & 7; LAS u32x2* d = (LAS u32x2*)(slot + SC_N + row * SC_NP + cc * 16); d[0] = (u32x2){o.n[j].x, o.n[j].y}; d[1] = (u32x2){o.n[j].z, o.n[j].w}; }
    if (lane < 16) *(LAS u32x4*)(slot + SC_G + lane * 16) = o.g;
}
constexpr int SC_RDY = SC_R * SC_SLOT, SC_PROG = SC_RDY + 64;
#if defined(HOST_EMU)
#define SPIN_YIELD() emu_yield()
#define EMU_PROGRESS() emu_note_progress()
#else
#define SPIN_YIELD() __builtin_amdgcn_s_sleep(1)
#define EMU_PROGRESS() do {} while (0)
#endif
DEV void rwkv_scan_block(const Ctx& C, int l, int unit) {
    const int sl = unit & 3, h = (unit >> 2) & 7, b = unit >> 5; int tid = C.tid;
#if !defined(HOST_EMU)
    asm volatile("" : "+v"(tid));
#endif
    const int lane = tid & 63, w = tid >> 6, fr = lane & 15, fq = lane >> 4, vd = 16 * sl + fr; LAS unsigned char* L = C.lds;
    volatile LAS unsigned* RDY = (volatile LAS unsigned*)(L + SC_RDY); volatile LAS unsigned* PROG = (volatile LAS unsigned*)(L + SC_PROG);
    const int item0 = (b * NCH) * 8 + h;
    if (tid < 32) RDY[tid] = 0u;
    __syncthreads();
    if (w >= 1) {
        ScanLd ldA, ldB; int k = w - 1;
        if (k < NCH) scan_ld_issue(C, ldA, item0 + 8 * k, sl, lane);
        if (k + SC_D < NCH) scan_ld_issue(C, ldB, item0 + 8 * (k + SC_D), sl, lane);
        for (; k < NCH; k += 2 * SC_D) {
            while ((int)*PROG < k - SC_R + 1) SPIN_YIELD();
            scan_ld_write(ldA, L + (k % SC_R) * SC_SLOT, lane);
            WAVE_SYNC(); asm volatile("" ::: "memory");
            if (lane == 0) RDY[k % SC_R] = (unsigned)(k + 1);
            EMU_PROGRESS();
            if (k + 2 * SC_D < NCH) scan_ld_issue(C, ldA, item0 + 8 * (k + 2 * SC_D), sl, lane);
            const int k2 = k + SC_D;
            if (k2 < NCH) {
                while ((int)*PROG < k2 - SC_R + 1) SPIN_YIELD();
                scan_ld_write(ldB, L + (k2 % SC_R) * SC_SLOT, lane);
                WAVE_SYNC(); asm volatile("" ::: "memory");
                if (lane == 0) RDY[k2 % SC_R] = (unsigned)(k2 + 1);
                EMU_PROGRESS();
                if (k2 + 2 * SC_D < NCH) scan_ld_issue(C, ldB, item0 + 8 * (k2 + 2 * SC_D), sl, lane); }
        }
    } else {
        f32x4 S[4];
#pragma unroll
        for (int mt = 0; mt < 4; ++mt) S[mt] = (f32x4){0.f, 0.f, 0.f, 0.f};
        for (int c = 0; c < NCH; ++c) {
            const LAS unsigned char* slot = L + (c % SC_R) * SC_SLOT; const int item = item0 + 8 * c;
            while (RDY[c % SC_R] != (unsigned)(c + 1)) SPIN_YIELD();
            asm volatile("" ::: "memory");
            u32x2 m0[4], m1[4], m2[4], m3[4]; f32x4 gam[4], nn[4];
#pragma unroll
            for (int mt = 0; mt < 4; ++mt) { const LAS unsigned char* mr = slot + SC_M + (16 * mt + fr) * SC_MP + 8 * fq;
                m0[mt] = *(const LAS u32x2*)(mr); m1[mt] = *(const LAS u32x2*)(mr + 32); m2[mt] = *(const LAS u32x2*)(mr + 64); m3[mt] = *(const LAS u32x2*)(mr + 96);
                gam[mt] = *(const LAS f32x4*)(slot + SC_G + (16 * mt + 4 * fq) * 4); nn[mt] = up4(*(const LAS u32x2*)(slot + SC_N + fr * SC_NP + (16 * mt + 4 * fq) * 2)); }
            WAVE_SYNC(); asm volatile("" ::: "memory");
            if (lane == 0) *PROG = (unsigned)(c + 1);
            EMU_PROGRESS();
            GAS bf16* S0 = WSP(bf16, WS_CHS) + (size_t)item * 4096 + vd * 64; u32x2 sb[4];
#pragma unroll
            for (int mt = 0; mt < 4; ++mt) { sb[mt] = pk4(S[mt]); *(GAS u32x2*)(S0 + 16 * mt + 4 * fq) = sb[mt]; }
            const bf16x8 b0 = mk8(sb[0], sb[1]), b1 = mk8(sb[2], sb[3]);
#pragma unroll
            for (int mt = 0; mt < 4; ++mt) { f32x4 acc = gam[mt] * S[mt] + nn[mt]; acc = MFMA16(mk8(m0[mt], m1[mt]), b0, acc); acc = MFMA16(mk8(m2[mt], m3[mt]), b1, acc); S[mt] = acc; }
        }
        GAS float* So = GOUT + O_PS + (((size_t)(l * BATCH + b) * 8 + h) * 64 + vd) * 64;
#pragma unroll
        for (int mt = 0; mt < 4; ++mt) *(GAS f32x4*)(So + 16 * mt + 4 * fq) = S[mt];
    }
    __syncthreads();
}

constexpr int AT_K = 0, AT_VT = 256 * PB, VTP = 528, AT_END = AT_VT + 64 * VTP;
static_assert(AT_END <= 131072, "attention LDS map");
DEV void attn_item(const Ctx& C, int l, int item) {
#if !defined(HOST_EMU)
    asm volatile("" : "+v"(item));
#endif
    const int qb = item % NQB, kvh = (item / NQB) & 1, b = item / (2 * NQB);
    int tid = C.tid;
#if !defined(HOST_EMU)
    asm volatile("" : "+v"(tid));
#endif
    const int lane = tid & 63, w = tid >> 6, fr = lane & 15, fq = lane >> 4; LAS unsigned char* L = C.lds;
    const GAS bf16* proj = WSP(bf16, WS_PROJ); const GAS float* rope = WSP(float, WS_ROPE);
    constexpr float QSC = 0.125f * 1.4426950408889634f;
    const int hq = kvh * 4 + (w >> 1), half = w & 1; const float sink = GIN(I_SINK)[l * 8 + hq] * 1.4426950408889634f;
    u32x4 qlo[4], qhi[4]; f32x4 qc[4][2], qs[4][2];
#pragma unroll
    for (int nt = 0; nt < 4; ++nt) { const int qpos_ = qb * 128 + 64 * half + 16 * nt + fr; const GAS bf16* qp = proj + ((size_t)b * SEQ + qpos_) * IN_PROJ + A_PROJ + hq * 64 + 8 * fq; const GAS float* rp = rope + (size_t)qpos_ * 64 + 8 * fq;
        qlo[nt] = *(const GAS u32x4*)qp; qhi[nt] = *(const GAS u32x4*)(qp + 32); qc[nt][0] = *(const GAS f32x4*)rp; qc[nt][1] = *(const GAS f32x4*)(rp + 4); qs[nt][0] = *(const GAS f32x4*)(rp + 32); qs[nt][1] = *(const GAS f32x4*)(rp + 36); }
    {
        const int key = tid >> 1, p = tid & 1; const int kpos = (qb - 1) * 128 + key; const bool ok = kpos >= 0;
        const GAS bf16* kr = proj + (size_t)(b * SEQ + (ok ? kpos : 0)) * IN_PROJ + A_PROJ + 512 + kvh * 64; const GAS bf16* vr = kr + 128;
        const bool wr = (qb == NQB - 1) && key >= 128; GAS float* ok_ = GOUT + O_PK + (((size_t)(l * BATCH + b) * 128 + (key - 128)) * 2 + kvh) * 64; GAS float* ov_ = GOUT + O_PV + (((size_t)(l * BATCH + b) * 128 + (key - 128)) * 2 + kvh) * 64;
        u32x4 klo[2], khi[2], vv4[4]; f32x4 rc[2][2], rsn[2][2];
        const GAS float* rpb = rope + (size_t)(ok ? kpos : 0) * 64;
#pragma unroll
        for (int hh = 0; hh < 2; ++hh) { const int d0 = 16 * p + 8 * hh; klo[hh] = (u32x4){0u, 0u, 0u, 0u}; khi[hh] = klo[hh]; if (ok) { klo[hh] = *(const GAS u32x4*)(kr + d0); khi[hh] = *(const GAS u32x4*)(kr + 32 + d0); }
            rc[hh][0] = *(const GAS f32x4*)(rpb + d0); rc[hh][1] = *(const GAS f32x4*)(rpb + d0 + 4); rsn[hh][0] = *(const GAS f32x4*)(rpb + 32 + d0); rsn[hh][1] = *(const GAS f32x4*)(rpb + 32 + d0 + 4); }
#pragma unroll
        for (int hh = 0; hh < 4; ++hh) { vv4[hh] = (u32x4){0u, 0u, 0u, 0u}; if (ok) vv4[hh] = *(const GAS u32x4*)(vr + 32 * p + 8 * hh); }
#pragma unroll
        for (int hh = 0; hh < 2; ++hh) { const int d0 = 16 * p + 8 * hh;
            const u32x4 lo = klo[hh], hi = khi[hh];
            float x1[8], x2[8], y1[8], y2[8];
#pragma unroll
            for (int j = 0; j < 4; ++j) { x1[2 * j] = bf2f(lo[j]); x1[2 * j + 1] = bf2f(lo[j] >> 16); x2[2 * j] = bf2f(hi[j]); x2[2 * j + 1] = bf2f(hi[j] >> 16); }
#pragma unroll
            for (int j = 0; j < 8; ++j) { const float cs = rc[hh][j >> 2][j & 3], sn = rsn[hh][j >> 2][j & 3]; y1[j] = x1[j] * cs - x2[j] * sn; y2[j] = x2[j] * cs + x1[j] * sn; }
            u32x4 o1, o2;
#pragma unroll
            for (int j = 0; j < 4; ++j) { o1[j] = pk2(y1[2 * j], y1[2 * j + 1]); o2[j] = pk2(y2[2 * j], y2[2 * j + 1]); }
            *(LAS u32x4*)(L + AT_K + key * PB + d0 * 2) = o1; *(LAS u32x4*)(L + AT_K + key * PB + (32 + d0) * 2) = o2;
            if (wr) {
#pragma unroll
                for (int j = 0; j < 8; ++j) { ok_[d0 + j] = y1[j]; ok_[32 + d0 + j] = y2[j]; } } }
#pragma unroll
        for (int hh = 0; hh < 4; ++hh) { const int d0 = 32 * p + 8 * hh; const u32x4 vv = vv4[hh];
#pragma unroll
            for (int j = 0; j < 4; ++j) { *(LAS bf16*)(L + AT_VT + (d0 + 2 * j) * VTP + key * 2) = (bf16)(vv[j] & 0xffffu); *(LAS bf16*)(L + AT_VT + (d0 + 2 * j + 1) * VTP + key * 2) = (bf16)(vv[j] >> 16);
                if (wr) { ov_[d0 + 2 * j] = bf2f(vv[j]); ov_[d0 + 2 * j + 1] = bf2f(vv[j] >> 16); } } }
    }
    __syncthreads();
    {
#pragma unroll
        for (int nt = 0; nt < 4; ++nt) {
            const int i0 = 64 * half + 16 * nt, iq = i0 + fr, qpos = qb * 128 + iq, t0 = i0 >> 4; const size_t qrow = (size_t)b * SEQ + qpos;
            bf16x8 q0, q1;
            { const u32x4 lo = qlo[nt], hi = qhi[nt];
              u32x4 o1, o2;
#pragma unroll
              for (int j = 0; j < 4; ++j) { const float xa = bf2f(lo[j]), xb_ = bf2f(lo[j] >> 16), ya = bf2f(hi[j]), yb_ = bf2f(hi[j] >> 16);
                  const float c0 = qc[nt][j >> 1][(2 * j) & 3], s0 = qs[nt][j >> 1][(2 * j) & 3], c1 = qc[nt][j >> 1][(2 * j + 1) & 3], s1 = qs[nt][j >> 1][(2 * j + 1) & 3];
                  o1[j] = pk2((xa * c0 - ya * s0) * QSC, (xb_ * c1 - yb_ * s1) * QSC); o2[j] = pk2((ya * c0 + xa * s0) * QSC, (yb_ * c1 + xb_ * s1) * QSC); }
              q0 = __builtin_bit_cast(bf16x8, o1); q1 = __builtin_bit_cast(bf16x8, o2); }
            f32x4 s[9]; float mx = -INFINITY;
#pragma unroll
            for (int r = 0; r < 9; ++r) { const int kt = t0 + r; f32x4 a = {0.f, 0.f, 0.f, 0.f};
                a = MFMA16(ldfrag(L + AT_K, 16 * kt + fr, 0, fq), q0, a); a = MFMA16(ldfrag(L + AT_K, 16 * kt + fr, 1, fq), q1, a);
                if (r == 0) {
#pragma unroll
                    for (int e = 0; e < 4; ++e) a[e] = (4 * fq + e > fr) ? a[e] : -INFINITY; }
                if (r == 8) {
#pragma unroll
                    for (int e = 0; e < 4; ++e) a[e] = (4 * fq + e <= fr) ? a[e] : -INFINITY; }
                if (qb == 0 && kt < 8) a = (f32x4){-INFINITY, -INFINITY, -INFINITY, -INFINITY};
#pragma unroll
                for (int e = 0; e < 4; ++e) mx = fmaxf(mx, a[e]);
                s[r] = a; }
            mx = fmaxf(mx, SHFLX(mx, 16)); mx = fmaxf(mx, SHFLX(mx, 32)); mx = fmaxf(mx, sink);
            float den = 0.f;
#pragma unroll
            for (int r = 0; r < 9; ++r)
#pragma unroll
                for (int e = 0; e < 4; ++e) { const float pe = fexp2(s[r][e] - mx); s[r][e] = pe; den += pe; }
            den += SHFLX(den, 16); den += SHFLX(den, 32); den += fexp2(sink - mx);
            f32x4 o[4];
#pragma unroll
            for (int dt = 0; dt < 4; ++dt) o[dt] = (f32x4){0.f, 0.f, 0.f, 0.f};
            const u32x2 z2 = {0u, 0u};
#pragma unroll
            for (int pr = 0; pr < 5; ++pr) { const int ra = 2 * pr, rb = 2 * pr + 1;
                const bf16x8 pb = mk8(pk4(s[ra]), (rb < 9) ? pk4(s[rb < 9 ? rb : 8]) : z2);
#pragma unroll
                for (int dt = 0; dt < 4; ++dt) { const LAS unsigned char* vp = L + AT_VT + (16 * dt + fr) * VTP;
                    const u32x2 alo = *(const LAS u32x2*)(vp + (16 * (t0 + ra) + 4 * fq) * 2), ahi = (rb < 9) ? *(const LAS u32x2*)(vp + (16 * (t0 + (rb < 9 ? rb : 8)) + 4 * fq) * 2) : z2;
                    o[dt] = MFMA16(mk8(alo, ahi), pb, o[dt]); } }
            const float rden = 1.0f / den; GAS bf16* op = WSP(bf16, WS_MIX) + qrow * D + 512 + hq * 64 + 4 * fq;
#pragma unroll
            for (int dt = 0; dt < 4; ++dt) *(GAS u32x2*)(op + 16 * dt) = pk4(o[dt] * rden);
        }
    }
    __syncthreads();
}

struct OutTile { bf16x8 p0, p1; u32x2 w4[4], pa[4], pv[4], g[4]; float rk; };
DEV void out_tile_load(const Ctx& C, OutTile& t, int item, int tt, int h, int c, int b, int fr, int fq) {
    const GAS bf16* P = WSP(bf16, WS_CHP) + (size_t)item * 4096 + (16 * tt + fr) * 64; const GAS bf16* W4 = WSP(bf16, WS_CHW) + (size_t)item * 4096 + (16 * tt + fr) * 64;
    const int tok = 64 * c + 16 * tt + fr; const size_t row = (size_t)b * SEQ + tok; const bool hp = tok > 0;
    const GAS bf16* pr = WSP(bf16, WS_PROJ) + row * IN_PROJ + 1024 + h * 64 + 4 * fq; const GAS bf16* gp = WSP(bf16, WS_G) + row * 512 + h * 64 + 4 * fq;
    t.p0 = *(const GAS bf16x8*)(P + 8 * fq); t.p1 = *(const GAS bf16x8*)(P + 32 + 8 * fq); t.rk = WSP(float, WS_RKR)[row * 8 + h];
#pragma unroll
    for (int mt = 0; mt < 4; ++mt) { t.w4[mt] = *(const GAS u32x2*)(W4 + 16 * mt + 4 * fq); t.pa[mt] = *(const GAS u32x2*)(pr + 16 * mt); t.pv[mt] = (u32x2){0u, 0u}; if (hp) t.pv[mt] = *(const GAS u32x2*)(pr - IN_PROJ + 16 * mt); t.g[mt] = *(const GAS u32x2*)(gp + 16 * mt); }
}
DEV void rwkv_out_item(const Ctx& C, int l, int item, bool handoff) {
#if !defined(HOST_EMU)
    asm volatile("" : "+v"(item));
#endif
    const int h = item & 7, c = (item >> 3) % NCH, b = (item >> 3) / NCH, lane = C.tid & 63, fr = lane & 15, fq = lane >> 4;
    const GAS bf16* S0 = WSP(bf16, WS_CHS) + (size_t)item * 4096;
    bf16x8 s0a[4], s0b[4]; f32x4 lg[4], lb[4], mv[4];
#if !defined(HOST_EMU)
#define LD_S0(p) ({ const GAS unsigned long long* q_ = (const GAS unsigned long long*)(p); const unsigned long long x_ = __hip_atomic_load(q_, __ATOMIC_RELAXED, __HIP_MEMORY_SCOPE_AGENT), y_ = __hip_atomic_load(q_ + 1, __ATOMIC_RELAXED, __HIP_MEMORY_SCOPE_AGENT); \
        u32x4 v_; v_.x = (unsigned)x_; v_.y = (unsigned)(x_ >> 32); v_.z = (unsigned)y_; v_.w = (unsigned)(y_ >> 32); __builtin_bit_cast(bf16x8, v_); })
    if (handoff) {
#pragma unroll
        for (int mt = 0; mt < 4; ++mt) { s0a[mt] = LD_S0(S0 + (16 * mt + fr) * 64 + 8 * fq); s0b[mt] = LD_S0(S0 + (16 * mt + fr) * 64 + 32 + 8 * fq); }
    } else
#undef LD_S0
#endif
    {
#pragma unroll
        for (int mt = 0; mt < 4; ++mt) { s0a[mt] = *(const GAS bf16x8*)(S0 + (16 * mt + fr) * 64 + 8 * fq); s0b[mt] = *(const GAS bf16x8*)(S0 + (16 * mt + fr) * 64 + 32 + 8 * fq); }
    }
#pragma unroll
    for (int mt = 0; mt < 4; ++mt) { const int cc = l * 512 + h * 64 + 16 * mt + 4 * fq;
        lg[mt] = *(const GAS f32x4*)(GIN(I_LNG) + cc); lb[mt] = *(const GAS f32x4*)(GIN(I_LNB) + cc); mv[mt] = *(const GAS f32x4*)(GIN(I_MU) + (size_t)l * A_PROJ + 1024 + h * 64 + 16 * mt + 4 * fq); }
    OutTile ta, tb; out_tile_load(C, ta, item, 0, h, c, b, fr, fq);
#define OUT_TILE(T, TT) do { f32x4 y[4]; float s1 = 0.f; \
        _Pragma("unroll") for (int mt = 0; mt < 4; ++mt) { f32x4 acc = up4(T.w4[mt]); acc = MFMA16(s0a[mt], T.p0, acc); acc = MFMA16(s0b[mt], T.p1, acc); y[mt] = acc; s1 += (acc[0] + acc[1]) + (acc[2] + acc[3]); } \
        s1 += SHFLX(s1, 16); s1 += SHFLX(s1, 32); const float mean = s1 * (1.0f / 64.0f); float s2 = 0.f; \
        _Pragma("unroll") for (int mt = 0; mt < 4; ++mt) { const f32x4 d = y[mt] - mean; s2 += (d[0] * d[0] + d[1] * d[1]) + (d[2] * d[2] + d[3] * d[3]); } \
        s2 += SHFLX(s2, 16); s2 += SHFLX(s2, 32); const float rstd = frsq(s2 * (1.0f / 64.0f) + LNX_EPS); \
        GAS bf16* op = WSP(bf16, WS_MIX) + ((size_t)b * SEQ + 64 * c + 16 * (TT) + fr) * D + h * 64 + 4 * fq; \
        _Pragma("unroll") for (int mt = 0; mt < 4; ++mt) { const f32x4 pa = up4(T.pa[mt]), pv = up4(T.pv[mt]); const f32x4 v = pa + mv[mt] * (pv - pa), g = up4(T.g[mt]); \
            const f32x4 yn = (y[mt] - mean) * rstd * lg[mt] + lb[mt]; *(GAS u32x2*)(op + 16 * mt) = pk4((yn + T.rk * v) * g); } } while (0)
    out_tile_load(C, tb, item, 1, h, c, b, fr, fq); OUT_TILE(ta, 0);
    out_tile_load(C, ta, item, 2, h, c, b, fr, fq); OUT_TILE(tb, 1);
    out_tile_load(C, tb, item, 3, h, c, b, fr, fq); OUT_TILE(ta, 2);
    OUT_TILE(tb, 3);
#undef OUT_TILE
}
DEV void rwkv_out_ticket(const Ctx& C, int l, int j) {
    const int w = C.tid >> 6;
#define ORD_ITEM(o) ((((o) % (BATCH * 8)) >> 3) * NCH + (o) / (BATCH * 8)) * 8 + (((o) % (BATCH * 8)) & 7)
    rwkv_out_item(C, l, ORD_ITEM(8 * j + w), false);
#undef ORD_ITEM
}
DEV void final_rows2(GAS float* ra, GAS float* rb, const GAS bf16* sa_, const GAS bf16* sb_, const GAS float* gain, int lane) {
    GAS f32x4* ya = (GAS f32x4*)ra + lane; GAS f32x4* yb = (GAS f32x4*)rb + lane; const GAS u32x2* xa = (const GAS u32x2*)sa_ + lane; const GAS u32x2* xb_ = (const GAS u32x2*)sb_ + lane;
    u32x2 ua[4], ub[4]; f32x4 g[4]; float sa = 0.f, sb = 0.f;
#pragma unroll
    for (int j = 0; j < 4; ++j) { ua[j] = xa[64 * j]; ub[j] = xb_[64 * j]; g[j] = ((const GAS f32x4*)gain)[lane + 64 * j]; }
    f32x4 va[4], vb[4];
#pragma unroll
    for (int j = 0; j < 4; ++j) { va[j] = up4(ua[j]); vb[j] = up4(ub[j]); sa += (va[j][0] * va[j][0] + va[j][1] * va[j][1]) + (va[j][2] * va[j][2] + va[j][3] * va[j][3]); sb += (vb[j][0] * vb[j][0] + vb[j][1] * vb[j][1]) + (vb[j][2] * vb[j][2] + vb[j][3] * vb[j][3]); }
    const float rsa = frsq(wave_sum(sa) * (1.0f / D) + NORM_EPS), rsb = frsq(wave_sum(sb) * (1.0f / D) + NORM_EPS);
#pragma unroll
    for (int j = 0; j < 4; ++j) { NT_ST(ya + 64 * j, va[j] * rsa * g[j]); if (rb != ra) NT_ST(yb + 64 * j, vb[j] * rsb * g[j]); }
}
#ifdef NO_SK
#define SKINNY(...) do {} while (0)
#else
#define SKINNY(...) skinny_gemm(C.lds, __VA_ARGS__)
#endif
constexpr int N_PHASES = 2 + 7 * DEPTH;
template <int PH> DEV void run_phase(const Ctx& C0) {
    Ctx C = C0;
#if !defined(HOST_EMU)
    asm volatile("" : "+v"(C.tid)); asm volatile("" : "+s"(C.ws), "+s"(C.out));
    C.lane = C.tid & 63; C.wave = __builtin_amdgcn_readfirstlane(C.tid >> 6);
#endif
    const int gw = C.bid * NWAVES + C.wave, NGW = C.G * NWAVES;
    if constexpr (PH == 0) {
#ifndef NO_P0
        phase_prologue(C);
#ifdef DBL_P0
        phase_prologue(C);
#endif
#endif
    } else if constexpr (PH == N_PHASES - 1) {
        for (int m = gw; m < MR; m += 2 * NGW) { const int m2 = (m + NGW < MR) ? m + NGW : m;
            final_rows2(GOUT + (m < MP ? O_YP + (size_t)m * D : O_YS + (size_t)(m - MP) * D), GOUT + (m2 < MP ? O_YP + (size_t)m2 * D : O_YS + (size_t)(m2 - MP) * D), WSP(bf16, WS_XB) + (size_t)m * D, WSP(bf16, WS_XB) + (size_t)m2 * D, GIN(I_FINAL), C.lane); }

    } else {
        constexpr int l = (PH - 1) / 7, s = (PH - 1) % 7;
        GAS bf16* xb = WSP(bf16, WS_XB); GAS float* part = WSP(float, WS_PART); GAS bf16* proj = WSP(bf16, WS_PROJ); GAS bf16* mix = WSP(bf16, WS_MIX); GAS bf16* hid = WSP(bf16, WS_HID);
        if constexpr (s == 0) {
            pg8::Gemm g{xb, WSP(bf16, WS_WIN) + (size_t)l * INP * D, MP + 256, INP, D}; pg8::StaticOrder S; S.init(MP + 256, INP, C.G, C.bid);
            EpiProj E{proj, part, WSP(float, WS_PARTS)}; pg8::gemm_phase<EpiProj, pg8::StaticOrder, true, true>(C.lds, g, S, E, C.tid);
        } else if constexpr (s == 1) {
            for (int grp = C.bid; grp < NITEM / 8; grp += C.G) {
                u32x4 lc[5];
#pragma unroll
                for (int j = 0; j < 5; ++j) lc[j] = (u32x4){0u, 0u, 0u, 0u};
#pragma clang loop unroll(disable)
                for (int hh = 0; hh < 8; ++hh) {
#ifndef NO_R2
                    rwkv_prep_item(C, l, grp * 8 + hh, lc, hh == 0);
#endif
                } }
        } else if constexpr (s == 2) {
            constexpr int nscan = BATCH * 8 * 4;
#ifndef NO_R3
            for (int sv = C.bid; sv < nscan; sv += C.G) rwkv_scan_block(C, l, sv);
            if (C.bid < nscan)
#ifdef DBL_SCAN
            for (int sv = C.bid; sv < nscan; sv += C.G) rwkv_scan_block(C, l, sv);
#endif
#endif
            __syncthreads();
            GAS unsigned* qhead = (GAS unsigned*)(C.ws + WS_CTL) + 16384 + 64 * (2 * l + 1 + 2 * DEPTH * C.qsel); LAS unsigned* qslot = (LAS unsigned*)(C.lds + MISC_OFF + 64);
            constexpr int natt = BATCH * 2 * NQB, nlist = natt + MS;
            const int nb = C.G - nscan, cb = C.bid - nscan, nstat = (nb > 0) ? ((2 * nb < nlist) ? 2 * nb : nlist) : 0;
            int sk = 0;
            for (;;) {
                int e;
                if (cb >= 0 && sk < 2 && cb + sk * nb < nstat) { e = cb + sk * nb; ++sk; }
                else {
                    sk = 2;
                    if (C.tid == 0) *qslot = atomicAdd((unsigned*)qhead, 1u);
                    __syncthreads();
                    e = nstat + (int)*qslot;
                    __syncthreads(); }
                if (e >= nlist + MS) break;
                if (e < natt) attn_item(C, l, e);
                else if (e < nlist) sample_mix_item(C, l, e - natt, 0);
                else sample_mix_item(C, l, e - nlist, 1); }
        } else if constexpr (s == 3) { for (int j = C.bid; j < NITEM / 8; j += C.G) rwkv_out_ticket(C, l, j);
        } else if constexpr (s == 4) {
            pg8::Gemm g{mix, WSP(bf16, WS_WOUT) + (size_t)l * D * D, MP, D, D}; pg8::StaticOrder S; S.init(MP, D, C.G, C.bid);
            const bool skfirst = ((C.bid >> 3) & 1) != 0;
            SkResid<false> Es{GOUT + O_YS, xb + (size_t)MP * D, WSP(float, WS_PARTS)};
            if (skfirst) { skinny_gemm_k8<D>(C.lds, mix + (size_t)MP * D, WSP(bf16, WS_WOUT) + (size_t)l * D * D, D, Es, C.tid); __syncthreads(); }
            EpiResid<false> E{GOUT + O_YP, xb, part}; pg8::gemm_phase<EpiResid<false>, pg8::StaticOrder, true, true>(C.lds, g, S, E, C.tid);
            if (!skfirst) skinny_gemm_k8<D>(C.lds, mix + (size_t)MP * D, WSP(bf16, WS_WOUT) + (size_t)l * D * D, D, Es, C.tid);
        } else if constexpr (s == 6) {
            constexpr bool lastl = false;
            pg8::Gemm g{hid, WSP(bf16, WS_WDN) + (size_t)l * D * FF, MP, D, FF}; pg8::StaticOrder S; S.init(MP, D, C.G, C.bid);
            const bool skfirst = ((C.bid >> 3) & 1) != 0;
            SkResid<lastl> Es{GOUT + O_YS, xb + (size_t)MP * D, WSP(float, WS_PARTS)};
            if (skfirst) { skinny_gemm_k8<FF>(C.lds, hid + (size_t)MP * FF, WSP(bf16, WS_WDN) + (size_t)l * D * FF, D, Es, C.tid); __syncthreads(); }
            EpiResid<lastl> E{GOUT + O_YP, xb, part}; pg8::gemm_phase<EpiResid<lastl>, pg8::StaticOrder, true, true>(C.lds, g, S, E, C.tid);
            if (!skfirst) skinny_gemm_k8<FF>(C.lds, hid + (size_t)MP * FF, WSP(bf16, WS_WDN) + (size_t)l * D * FF, D, Es, C.tid);
        } else {
            { int G2 = (int)gridDim.x, me = (int)gridDim.x - 1 - (int)blockIdx.x;
#if !defined(HOST_EMU)
              asm volatile("" : "+s"(G2), "+s"(me));
#endif
              constexpr int nwg = ((MP + 256) / 256) * (GU / 256); const int nidle = ((nwg + G2 - 1) / G2) * G2 - nwg, nwk = (nidle > 0) ? nidle : G2;
              if (me < nwk) for (int it = me; it < 2 * MS; it += nwk) cache_shift_item(C, l, it); }
            pg8::Gemm g{xb, WSP(bf16, WS_WGU) + (size_t)l * GU * D, MP + 256, GU, D}; pg8::StaticOrder S; S.init(MP + 256, GU, C.G, C.bid);
            EpiGU E{hid, part, WSP(float, WS_PARTS)}; pg8::gemm_phase<EpiGU, pg8::StaticOrder, true, true>(C.lds, g, S, E, C.tid);
        }
    }
}
#if !defined(HOST_EMU)
#define GRID_BAR() xcd_barrier(bar)
#else
#define GRID_BAR() do {} while (0)
#endif
#if !defined(HOST_EMU)
template <int PH> DEV void run_from(const Ctx& C0, const int lo, const int hi, const XcdBarrier& bar) {
#else
template <int PH> DEV void run_from(const Ctx& C0, const int lo, const int hi, const int& bar) {
#endif
    if constexpr (PH < N_PHASES) {
        if (PH >= lo && PH < hi) { run_phase<PH>(C0);
#ifdef DBL_S
            if constexpr (PH >= 1 && PH < N_PHASES - 1 && ((PH - 1) % 7) == DBL_S) { GRID_BAR(); Ctx C1 = C0; C1.qsel = 1; run_phase<PH>(C1); }
#endif
#ifdef DBL_PH
            if constexpr (PH == DBL_PH) { GRID_BAR(); run_phase<PH>(C0); }
#endif
#ifdef XBAR
            if constexpr (PH >= 1 && PH < N_PHASES - 1 && ((PH - 1) % 7) == 3) { for (int xb_ = 0; xb_ < XBAR; ++xb_) GRID_BAR(); }
#endif
            if (PH + 1 < hi) GRID_BAR(); }
        run_from<PH + 1>(C0, lo, hi, bar);
    }
}
__global__ void __launch_bounds__(NWAVES * 64, 2) hybrid_fwd(Args args) {
#if defined(HOST_EMU)
    GAS unsigned char* lds = emu_lds;
#else
    extern __shared__ __attribute__((aligned(16))) unsigned char lds[];
#endif
    Ctx C; C.in = args.in; C.out = args.out; C.ws = args.ws; C.lds = (LAS unsigned char*)lds; C.tid = threadIdx.x; C.lane = C.tid & 63; C.wave = __builtin_amdgcn_readfirstlane(C.tid >> 6);
    C.G = gridDim.x; C.bid = blockIdx.x; C.qsel = 0;
#if !defined(HOST_EMU)
    volatile LAS unsigned* MISC = (volatile LAS unsigned*)(C.lds + MISC_OFF);
    for (int u = C.tid; u < (LDS_BYTES - 131072) / 4; u += NWAVES * 64) ((LAS unsigned*)(C.lds + 131072))[u] = 0u;
    __syncthreads();
    XcdBarrier bar = xcd_barrier_post((GAS unsigned*)(C.ws + WS_CTL) + 4096, MISC + 8);
#else
    int bar = 0;
#endif
    run_from<0>(C, args.ph_lo, args.ph_hi, bar);
}

extern "C" void kernel_launch(void* const* d_in, const int* in_sizes, int n_in, void* d_out, int out_size, void* d_ws, size_t ws_size, hipStream_t stream) {
    static int grid = 0;
    if (grid == 0) {
        if (n_in != N_IN || (size_t)out_size != O_END || ws_size < WS_END) { fprintf(stderr, "kernel_launch: shape mismatch: n_in %d out %d (want %zu) ws %zu (want %zu)\n", n_in, out_size, (size_t)O_END, ws_size, (size_t)WS_END); grid = -1; return; }
#if defined(HOST_EMU)
        grid = 3;
#else
        int dev = 0, cus = 0;
        if (hipGetDevice(&dev) != hipSuccess || hipDeviceGetAttribute(&cus, hipDeviceAttributeMultiprocessorCount, dev) != hipSuccess) { grid = -1; return; }
        if (hipFuncSetAttribute((const void*)hybrid_fwd, hipFuncAttributeMaxDynamicSharedMemorySize, LDS_BYTES) != hipSuccess) { fprintf(stderr, "kernel_launch: hipFuncSetAttribute failed\n"); grid = -1; return; }
        int per_cu = 0; (void)hipOccupancyMaxActiveBlocksPerMultiprocessor(&per_cu, (const void*)hybrid_fwd, NWAVES * 64, LDS_BYTES); (void)hipGetLastError();
        grid = cus;
#endif
    }
    if (grid < 0) return;
    (void)hipMemsetAsync((char*)d_ws + WS_CTL, 0, CTL_BYTES, stream);
    Args a; memset(&a, 0, sizeof(a));
    for (int i = 0; i < N_IN; ++i) a.in[i] = (const float*)d_in[i];
    a.out = (float*)d_out; a.ws = (unsigned char*)d_ws;
#if PH_PER_LAUNCH || defined(HOST_EMU)
    for (int ph = 0; ph < N_PHASES; ++ph) { a.ph_lo = ph; a.ph_hi = ph + 1;
#if defined(HOST_EMU)
        fprintf(stderr, "phase %d\n", ph); emu_launch([&] { hybrid_fwd(a); }, dim3(grid), dim3(NWAVES * 64), LDS_BYTES);
#else
        (void)hipMemsetAsync((char*)d_ws + WS_CTL, 0, CTL_BYTES, stream);
        hipLaunchKernelGGL(hybrid_fwd, dim3(grid), dim3(NWAVES * 64), LDS_BYTES, stream, a);
#endif
    }
#else
    a.ph_lo = 0; a.ph_hi = N_PHASES;
    hipLaunchKernelGGL(hybrid_fwd, dim3(grid), dim3(NWAVES * 64), LDS_BYTES, stream, a);
#endif
}
```

```cpp
#if defined(HOST_EMU)
#include "emu.h"
#else
#include <hip/hip_runtime.h>
#include <cstdio>
#include <cstdint>
#include <cmath>
#include <cstring>
#define LAS __attribute__((address_space(3)))
#if defined(__HIP_DEVICE_COMPILE__)
#define GAS __attribute__((address_space(1)))
#else
#define GAS
#endif
#define WAVE_SYNC() asm volatile("s_waitcnt lgkmcnt(0)" ::: "memory")
#define MFMA16(a, b, c) __builtin_amdgcn_mfma_f32_16x16x32_bf16(a, b, c, 0, 0, 0)
#define SHFLX(v, m) __shfl_xor(v, m)
#define SHFL(v, s) __shfl(v, s)
#endif
#define DEV __device__ __forceinline__
#if defined(__HIP_DEVICE_COMPILE__) && !defined(HOST_EMU)
#define NT_LD(p) (*(p))
#define NT_ST(p, v) __builtin_nontemporal_store((v), (p))
#else
#define NT_LD(p) (*(p))
#define NT_ST(p, v) (*(p) = (v))
#endif
#if defined(HOST_EMU)
#define GAS
#endif
#define AS_G(T, p) ((T*)(GAS T*)(p))

#ifndef SEQ
#define SEQ 8192
#endif
#ifndef DEPTH
#define DEPTH 4
#endif
#ifndef DEC_BATCH
#define DEC_BATCH 128
#endif
#ifndef PH_PER_LAUNCH
#define PH_PER_LAUNCH 0
#endif
constexpr int BATCH = 2, D = 1024, A_PROJ = 1824, IN_PROJ = 2592, INP = 2816, FF = 2816, GU = 5632;
constexpr int MP = BATCH * SEQ, MS = DEC_BATCH, MR = MP + MS, PAST_LEN = 8192;
constexpr int NCH = SEQ / 64, NQB = SEQ / 128, NITEM = BATCH * NCH * 8;
constexpr float NORM_EPS = 1e-5f, LNX_EPS = 64e-5f;
static_assert(SEQ % 128 == 0 && MP % 256 == 0 && MS % 16 == 0 && MS <= 128, "shape constraints");
enum { I_XP = 0, I_XS, I_SRWKV, I_SSHIFT, I_CK, I_CV, I_ANORM, I_WIN, I_MU, I_W0, I_WDEC, I_A0, I_WA, I_WG, I_KK, I_KA, I_RK, I_LNG, I_LNB, I_SINK, I_WOUT, I_FNORM, I_WGATE, I_WUP, I_WDOWN, I_FINAL, N_IN };
constexpr size_t O_YP = 0, O_YS = O_YP + (size_t)MP * D, O_PS = O_YS + (size_t)MS * D, O_PSH = O_PS + (size_t)DEPTH * BATCH * 32768,
                 O_PK = O_PSH + (size_t)DEPTH * BATCH * A_PROJ, O_PV = O_PK + (size_t)DEPTH * BATCH * 16384, O_SS = O_PV + (size_t)DEPTH * BATCH * 16384,
                 O_SSH = O_SS + (size_t)DEPTH * MS * 32768, O_SK = O_SSH + (size_t)DEPTH * MS * A_PROJ, O_SV = O_SK + (size_t)DEPTH * MS * 16384,
                 O_END = O_SV + (size_t)DEPTH * MS * 16384;
constexpr size_t al256(size_t x) { return (x + 255) & ~(size_t)255; }
constexpr size_t WS_CTL = 0, CTL_BYTES = 1u << 20;
constexpr size_t WS_WIN = WS_CTL + CTL_BYTES, WS_WOUT = WS_WIN + (size_t)DEPTH * INP * D * 2, WS_WGU = WS_WOUT + (size_t)DEPTH * D * D * 2,
                 WS_WDN = WS_WGU + (size_t)DEPTH * GU * D * 2, WS_WLD = WS_WDN + (size_t)DEPTH * D * FF * 2, WS_WLA = WS_WLD + (size_t)DEPTH * 512 * 64 * 2,
                 WS_WLG = WS_WLA + (size_t)DEPTH * 512 * 64 * 2, WS_ROPE = WS_WLG + (size_t)DEPTH * 512 * 160 * 2,
                 WS_XB = al256(WS_ROPE + (size_t)(SEQ + 1) * 64 * 4), WS_PART = al256(WS_XB + (size_t)MR * D * 2), WS_PARTS = al256(WS_PART + (size_t)MR * 16 * 4), WS_MIX = al256(WS_PARTS + (size_t)MS * 32 * 4),
                 WS_G = al256(WS_MIX + (size_t)MR * D * 2), WS_RKR = al256(WS_G + (size_t)MP * 512 * 2), WS_PROJ = al256(WS_RKR + (size_t)MP * 8 * 4),
                 WS_CHP = al256(WS_PROJ + (size_t)MR * IN_PROJ * 2), WS_CHW = WS_CHP + (size_t)NITEM * 8192, WS_CHM = WS_CHW + (size_t)NITEM * 8192,
                 WS_CHS = WS_CHM + (size_t)NITEM * 8192, WS_CHN = WS_CHS + (size_t)NITEM * 8192, WS_CHG = WS_CHN + (size_t)NITEM * 16384,
                 WS_END0 = al256(WS_CHG + (size_t)NITEM * 256), WS_HID = WS_PROJ  ,
                 WS_END = (WS_HID + (size_t)MR * FF * 2 > WS_END0) ? al256(WS_HID + (size_t)MR * FF * 2) : WS_END0;

typedef unsigned short bf16;
typedef short bf16x8 __attribute__((ext_vector_type(8)));
typedef float f32x4 __attribute__((ext_vector_type(4)));
typedef unsigned u32x4 __attribute__((ext_vector_type(4)));
typedef unsigned u32x2 __attribute__((ext_vector_type(2)));

#if defined(HOST_EMU)
DEV unsigned f2bf(float f) { unsigned u = __builtin_bit_cast(unsigned, f); return (u + 0x7fffu + ((u >> 16) & 1u)) >> 16; }
DEV unsigned pk2(float lo, float hi) { return f2bf(lo) | (f2bf(hi) << 16); }
#else
typedef float f32x2_t __attribute__((ext_vector_type(2))); typedef __bf16 bf16x2_t __attribute__((ext_vector_type(2)));
DEV unsigned pk2(float lo, float hi) { const f32x2_t v = {lo, hi}; const bf16x2_t b = __builtin_convertvector(v, bf16x2_t); return __builtin_bit_cast(unsigned, b); }
DEV unsigned f2bf(float f) { return pk2(f, 0.f) & 0xffffu; }
#endif
DEV float bf2f(unsigned h) { return __builtin_bit_cast(float, (h & 0xffffu) << 16); }
DEV u32x2 pk4(f32x4 v) { u32x2 r; r.x = pk2(v[0], v[1]); r.y = pk2(v[2], v[3]); return r; }
DEV f32x4 up4(u32x2 w) { f32x4 r; r[0] = bf2f(w.x); r[1] = bf2f(w.x >> 16); r[2] = bf2f(w.y); r[3] = bf2f(w.y >> 16); return r; }
DEV float wave_sum(float v) {
#pragma unroll
    for (int o = 1; o < 64; o <<= 1) v += SHFLX(v, o);
    return v; }
DEV float wave_max(float v) {
#pragma unroll
    for (int o = 1; o < 64; o <<= 1) v = fmaxf(v, SHFLX(v, o));
    return v; }
#if defined(HOST_EMU)
DEV float fexp(float x) { return expf(x); }
DEV float flog(float x) { return logf(x); }
DEV float frcp(float x) { return 1.0f / x; }
DEV float frsq(float x) { return 1.0f / sqrtf(x); }
DEV float fexp2(float x) { return exp2f(x); }
#else
DEV float fexp(float x) { return __builtin_amdgcn_exp2f(x * 1.4426950408889634f); }
DEV float flog(float x) { return __builtin_amdgcn_logf(x) * 0.6931471805599453f; }
DEV float frcp(float x) { return __builtin_amdgcn_rcpf(x); }
DEV float fexp2(float x) { return __builtin_amdgcn_exp2f(x); }
DEV float frsq(float x) { return __builtin_amdgcn_rsqf(x); }
#endif
DEV float sigmoidf_(float x) { return frcp(1.0f + fexp(-x)); }
DEV float tanhf_(float x) { return 2.0f * frcp(1.0f + fexp(-2.0f * x)) - 1.0f; }
DEV float softplusf_(float x) { return x > 20.f ? x : flog(1.0f + fexp(x)); }
DEV float siluf_(float x) { return x * frcp(1.0f + fexp(-x)); }
typedef float f32x2 __attribute__((ext_vector_type(2)));
DEV u32x2 swiglu4(f32x4 a, f32x4 b, float rsl, float rs2) {
    const f32x2 g01 = {a[0], a[2]}, u01 = {a[1], a[3]}, g23 = {b[0], b[2]}, u23 = {b[1], b[3]};
    const f32x2 t01 = g01 * rsl, t23 = g23 * rsl; const f32x2 d01 = (f32x2){fexp2(t01.x), fexp2(t01.y)} + 1.0f, d23 = (f32x2){fexp2(t23.x), fexp2(t23.y)} + 1.0f;
    const f32x2 r01 = (f32x2){frcp(d01.x), frcp(d01.y)} * rs2, r23 = (f32x2){frcp(d23.x), frcp(d23.y)} * rs2; const f32x2 h01 = (g01 * u01) * r01, h23 = (g23 * u23) * r23;
    u32x2 w; w.x = pk2(h01.x, h01.y); w.y = pk2(h23.x, h23.y); return w; }
DEV bf16x8 mk8(u32x2 lo, u32x2 hi) { u32x4 w; w.x = lo.x; w.y = lo.y; w.z = hi.x; w.w = hi.y; return __builtin_bit_cast(bf16x8, w); }

namespace pg8 {
constexpr int BM = 256, BK = 64, HALF = 128, HTB = HALF * BK * 2, STAGE_BYTES = 8 * HTB, NXCD = 8, WGM = 8;
__host__ __device__ __forceinline__ int lds_byte(int r, int c) { const int st = (r >> 4) * 2 + (c >> 5), rr = r & 15, cc = c & 31, ob = rr * 64 + cc * 2; return st * 1024 + (ob ^ (((ob >> 9) & 1) << 5)); }
__host__ __device__ __forceinline__ void stage_rc(int b, int& R, int& C) { const int st = b / 1024, sb = b % 1024, swz = sb ^ (((sb >> 9) & 1) << 5); R = (st >> 1) * 16 + swz / 64; C = (st & 1) * 32 + (swz % 64) / 2; }
__host__ __device__ __forceinline__ int perm32(int rho) { const int n = rho >> 4, i = rho & 15; return 8 * (i >> 2) + 4 * n + (i & 3); }
struct Unit { int pm, pn; };
struct Gemm { const bf16* A; const bf16* Bt; int M, N, K; };
struct StaticOrder {
    int nM, nN, nwg, G, c;
    __host__ __device__ void init(int M, int N, int G_, int c_) { nM = M / BM; nN = N / BM; nwg = nM * nN; G = G_; c = c_; }
    __host__ __device__ bool next(int i, Unit& u) const {
        const long L = (long)i * G + c; if (L >= nwg) return false;
        int wgid = (int)L; { const int q = nwg / NXCD, r = nwg % NXCD, xcd = wgid % NXCD, off = wgid / NXCD; wgid = (xcd < r ? xcd * (q + 1) : r * (q + 1) + (xcd - r) * q) + off; }
        const int nig = WGM * nN, gid = wgid / nig, fm = gid * WGM, gsz = (nM - fm) < WGM ? (nM - fm) : WGM;
        u.pm = fm + ((wgid % nig) % gsz); u.pn = (wgid % nig) / gsz; return true;
    }
    __device__ __forceinline__ void a_ready(const Unit&) const {}
    __device__ __forceinline__ void done(const Unit&) const {}
};
#if !defined(HOST_EMU)
template <class Epi, class Sched, bool ALIGN_EPI = false, bool SP2 = false>
__device__ __forceinline__ void gemm_phase(LAS unsigned char* lds, const Gemm g, const Sched& S, const Epi& E, const int tid) {
    const int wid = __builtin_amdgcn_readfirstlane(tid >> 6), lane = tid & 63, wr = wid >> 2, wc = wid & 3, fr = lane & 15, fq = lane >> 4;
    const int K = g.K, nt = K / BK;
    unsigned voffA[2], voffB[2];
#pragma unroll
    for (int i = 0; i < 2; ++i) { int R, C; stage_rc(tid * 16 + i * 8192, R, C); const int Rb = Epi::PERM ? ((R & ~31) + perm32(R & 31)) : R;
        voffA[i] = (unsigned)(R * K + C) * 2u; voffB[i] = (unsigned)(Rb * K + C) * 2u; }
    const size_t kstep = (size_t)(BK * 2);
    const size_t hstep = (size_t)HALF * K * 2;
    const size_t tstep = 2 * hstep;
    const unsigned ldsw = (unsigned)wid * 1024u;
    const int aoff = lds_byte(wr * 64 + fr, fq * 8), boff = lds_byte(wc * 32 + fr, fq * 8);
#define PG8_SA(b, h) (((b) * 2 + (h)) * HTB)
#define PG8_SB(b, h) ((4 + (b) * 2 + (h)) * HTB)
#define PG8_STAGE(bufoff, gbase, voff) do { _Pragma("unroll") for (int _i = 0; _i < 2; ++_i) \
        __builtin_amdgcn_global_load_lds((const unsigned*)((const char*)(gbase) + (voff)[_i]), (LAS unsigned*)(lds + (bufoff) + ldsw + _i * 8192), 16, 0, 0); } while (0)
#define PG8_LDA(dst, b, h) do { _Pragma("unroll") for (int m = 0; m < 4; ++m) _Pragma("unroll") for (int k = 0; k < 2; ++k) dst[m][k] = *(const LAS bf16x8*)(lds + PG8_SA(b, h) + aoff + m * 2048 + k * 1024); } while (0)
#define PG8_LDB(dst, b, h) do { _Pragma("unroll") for (int n = 0; n < 2; ++n) _Pragma("unroll") for (int k = 0; k < 2; ++k) dst[n][k] = *(const LAS bf16x8*)(lds + PG8_SB(b, h) + boff + n * 2048 + k * 1024); } while (0)
#define PG8_MMA(ai, bj, At, Bt) do { __builtin_amdgcn_s_setprio(1); _Pragma("unroll") for (int m = 0; m < 4; ++m) _Pragma("unroll") for (int n = 0; n < 2; ++n) _Pragma("unroll") for (int k = 0; k < 2; ++k) \
        acc[ai][bj][m][n] = __builtin_amdgcn_mfma_f32_16x16x32_bf16(Bt[n][k], At[m][k], acc[ai][bj][m][n], 0, 0, 0); __builtin_amdgcn_s_setprio(0); } while (0)
#define PG8_WAIT_V(n) asm volatile("s_waitcnt vmcnt(" #n ")" ::: "memory")
#define PG8_WAIT_L(n) asm volatile("s_waitcnt lgkmcnt(" #n ")" ::: "memory")
#define PG8_BAR __builtin_amdgcn_s_barrier()
#define PG8_SCHED __builtin_amdgcn_sched_barrier(0)
    Unit cur, nxt; int ui = 0;
    if (!S.next(0, cur)) return;
    f32x4 acc[2][2][4][2];
#pragma unroll
    for (int a = 0; a < 2; ++a)
#pragma unroll
        for (int b = 0; b < 2; ++b)
#pragma unroll
            for (int m = 0; m < 4; ++m)
#pragma unroll
                for (int n = 0; n < 2; ++n) acc[a][b][m][n] = (f32x4){0.f, 0.f, 0.f, 0.f};
    bf16x8 At[4][2], B0[2][2], B1[2][2];
    const char* cA = (const char*)g.A + (size_t)cur.pm * tstep; const char* cB = (const char*)g.Bt + (size_t)cur.pn * tstep;
    S.a_ready(cur);
    if constexpr (SP2) {
        PG8_STAGE(PG8_SB(0, 0), cB, voffB); PG8_STAGE(PG8_SB(0, 1), cB + hstep, voffB); PG8_STAGE(PG8_SA(0, 0), cA, voffA); PG8_STAGE(PG8_SA(0, 1), cA + hstep, voffA);
        if (wr == 1) PG8_BAR;
        PG8_WAIT_V(2); PG8_BAR;
        PG8_STAGE(PG8_SB(1, 0), cB + kstep, voffB); PG8_STAGE(PG8_SA(1, 0), cA + kstep, voffA); PG8_STAGE(PG8_SB(1, 1), cB + hstep + kstep, voffB);
        PG8_WAIT_V(6); PG8_BAR;
    } else {
        PG8_STAGE(PG8_SB(0, 0), cB, voffB); PG8_STAGE(PG8_SA(0, 0), cA, voffA); PG8_STAGE(PG8_SB(0, 1), cB + hstep, voffB); PG8_STAGE(PG8_SA(0, 1), cA + hstep, voffA);
        if (wr == 1) PG8_BAR;
        PG8_WAIT_V(4); PG8_BAR;
        PG8_STAGE(PG8_SB(1, 0), cB + kstep, voffB); PG8_STAGE(PG8_SA(1, 0), cA + kstep, voffA); PG8_STAGE(PG8_SB(1, 1), cB + hstep + kstep, voffB);
        PG8_WAIT_V(6); PG8_BAR;
    }
    for (;;) {
        const bool has_next = S.next(ui + 1, nxt);
        const char* nA = has_next ? (const char*)g.A + (size_t)nxt.pm * tstep : cA; const char* nB = has_next ? (const char*)g.Bt + (size_t)nxt.pn * tstep : cB;
        for (int t = 0; t < nt; t += 2) {
            const bool last = (t == nt - 2);
            const char* a1 = cA + (size_t)(t + 1) * kstep;
            const char* a2 = last ? nA : cA + (size_t)(t + 2) * kstep; const char* b2 = last ? nB : cB + (size_t)(t + 2) * kstep;
            const char* a3 = a2 + kstep; const char* b3 = b2 + kstep;
            if (last && has_next) S.a_ready(nxt);
            if constexpr (SP2) {
            PG8_LDB(B0, 0, 0); PG8_LDB(B1, 0, 1); PG8_SCHED; PG8_LDA(At, 0, 0); PG8_STAGE(PG8_SA(1, 1), a1 + hstep, voffA);
            PG8_WAIT_V(8); PG8_WAIT_L(0); PG8_BAR; PG8_MMA(0, 0, At, B0); PG8_MMA(0, 1, At, B1); PG8_BAR; PG8_SCHED;
            PG8_LDA(At, 0, 1); PG8_STAGE(PG8_SB(0, 0), b2, voffB); PG8_STAGE(PG8_SB(0, 1), b2 + hstep, voffB); PG8_STAGE(PG8_SA(0, 0), a2, voffA);
            PG8_WAIT_V(8); PG8_WAIT_L(0); PG8_BAR; PG8_MMA(1, 0, At, B0); PG8_MMA(1, 1, At, B1); PG8_BAR; PG8_SCHED;
            PG8_LDB(B0, 1, 0); PG8_LDB(B1, 1, 1); PG8_SCHED; PG8_LDA(At, 1, 0); PG8_STAGE(PG8_SA(0, 1), a2 + hstep, voffA);
            PG8_WAIT_V(8); PG8_WAIT_L(0); PG8_BAR; PG8_MMA(0, 0, At, B0); PG8_MMA(0, 1, At, B1); PG8_BAR; PG8_SCHED;
            PG8_LDA(At, 1, 1); PG8_STAGE(PG8_SB(1, 0), b3, voffB); PG8_STAGE(PG8_SB(1, 1), b3 + hstep, voffB); PG8_STAGE(PG8_SA(1, 0), a3, voffA);
            PG8_WAIT_V(8); PG8_WAIT_L(0); PG8_BAR; PG8_MMA(1, 0, At, B0); PG8_MMA(1, 1, At, B1); PG8_BAR; PG8_SCHED;
            } else {
            PG8_LDB(B0, 0, 0); PG8_SCHED; PG8_LDA(At, 0, 0); PG8_STAGE(PG8_SA(1, 1), a1 + hstep, voffA);
            PG8_WAIT_L(8); PG8_BAR; PG8_WAIT_L(0); PG8_MMA(0, 0, At, B0); PG8_BAR; PG8_SCHED;
            PG8_LDB(B1, 0, 1); PG8_STAGE(PG8_SB(0, 0), b2, voffB);
            PG8_BAR; PG8_WAIT_L(0); PG8_MMA(0, 1, At, B1); PG8_BAR;
            PG8_LDA(At, 0, 1); PG8_STAGE(PG8_SA(0, 0), a2, voffA);
            PG8_BAR; PG8_WAIT_L(0); PG8_MMA(1, 0, At, B0); PG8_BAR; PG8_SCHED;
            PG8_STAGE(PG8_SB(0, 1), b2 + hstep, voffB);
            PG8_WAIT_V(6); PG8_BAR; PG8_MMA(1, 1, At, B1); PG8_BAR;
            PG8_LDB(B0, 1, 0); PG8_SCHED; PG8_LDA(At, 1, 0); PG8_STAGE(PG8_SA(0, 1), a2 + hstep, voffA);
            PG8_WAIT_L(8); PG8_BAR; PG8_WAIT_L(0); PG8_MMA(0, 0, At, B0); PG8_BAR; PG8_SCHED;
            PG8_LDB(B1, 1, 1); PG8_STAGE(PG8_SB(1, 0), b3, voffB);
            PG8_BAR; PG8_WAIT_L(0); PG8_MMA(0, 1, At, B1); PG8_BAR;
            PG8_LDA(At, 1, 1); PG8_STAGE(PG8_SA(1, 0), a3, voffA);
            PG8_BAR; PG8_WAIT_L(0); PG8_MMA(1, 0, At, B0); PG8_BAR; PG8_SCHED;
            PG8_STAGE(PG8_SB(1, 1), b3 + hstep, voffB);
            PG8_WAIT_V(6); PG8_BAR; PG8_MMA(1, 1, At, B1); PG8_BAR;
            }
        }
        if constexpr (ALIGN_EPI) { if (wr == 0) PG8_BAR; }
        E(acc, cur, wr, wc, fr, fq); S.done(cur);
        if (!has_next) break;
#pragma unroll
        for (int a = 0; a < 2; ++a)
#pragma unroll
            for (int b = 0; b < 2; ++b)
#pragma unroll
                for (int m = 0; m < 4; ++m)
#pragma unroll
                    for (int n = 0; n < 2; ++n) acc[a][b][m][n] = (f32x4){0.f, 0.f, 0.f, 0.f};
        cur = nxt; cA = nA; cB = nB; ++ui;
        if constexpr (ALIGN_EPI) { if (wr == 1) PG8_BAR; }
    }
    PG8_WAIT_V(0);
    if constexpr (!ALIGN_EPI) { if (wr == 0) PG8_BAR; }
    PG8_BAR;
#undef PG8_SA
#undef PG8_SB
#undef PG8_STAGE
#undef PG8_LDA
#undef PG8_LDB
#undef PG8_MMA
#undef PG8_WAIT_V
#undef PG8_WAIT_L
#undef PG8_BAR
#undef PG8_SCHED
}
#else
template <class Epi, class Sched, bool ALIGN_EPI = false, bool SP2 = false>
inline void gemm_phase(LAS unsigned char* lds, const Gemm g, const Sched& S, const Epi& E, const int tid) {
    const int wid = tid >> 6, lane = tid & 63, wr = wid >> 2, wc = wid & 3, fr = lane & 15, fq = lane >> 4;
    Unit u;
    for (int i = 0; S.next(i, u); ++i) {
        f32x4 acc[2][2][4][2];
        for (int ai = 0; ai < 2; ++ai) for (int bj = 0; bj < 2; ++bj) for (int m = 0; m < 4; ++m) for (int n = 0; n < 2; ++n) for (int e = 0; e < 4; ++e) {
            const int r = 256 * u.pm + 128 * ai + 64 * wr + 16 * m + fr, c = 256 * u.pn + 128 * bj + 32 * wc + 8 * fq + 4 * n + e; float s = 0.f;
            const bf16* a = g.A + (size_t)r * g.K; const bf16* b = g.Bt + (size_t)c * g.K;
            for (int k = 0; k < g.K; ++k) s += bf2f(a[k]) * bf2f(b[k]);
            acc[ai][bj][m][n][e] = s; }
        E(acc, u, wr, wc, fr, fq);
    }
    __syncthreads();
}
#endif
}

DEV float rstd_from_part(const GAS float* part, int row) {
    const GAS f32x4* p = (const GAS f32x4*)(part + (size_t)row * 16); f32x4 a = p[0], b = p[1], c = p[2], d = p[3];
    const float s = ((a[0] + a[1]) + (a[2] + a[3])) + ((b[0] + b[1]) + (b[2] + b[3])) + ((c[0] + c[1]) + (c[2] + c[3])) + ((d[0] + d[1]) + (d[2] + d[3]));
    return frsq(s * (1.0f / D) + NORM_EPS);
}
DEV void rstd4_from_part(const GAS float* part, int row0, float (&rs)[4]) {
    f32x4 pp[4][4];
#pragma unroll
    for (int g = 0; g < 4; ++g) { const GAS f32x4* p = (const GAS f32x4*)(part + (size_t)(row0 + 16 * g) * 16);
#pragma unroll
        for (int j = 0; j < 4; ++j) pp[g][j] = p[j]; }
#pragma unroll
    for (int g = 0; g < 4; ++g) { float s = 0.f;
#pragma unroll
        for (int j = 0; j < 4; ++j) s += (pp[g][j][0] + pp[g][j][1]) + (pp[g][j][2] + pp[g][j][3]);
        rs[g] = frsq(s * (1.0f / D) + NORM_EPS); }
}
DEV float rstd_from_part32(const GAS float* part, int row) {
    const GAS f32x4* p = (const GAS f32x4*)(part + (size_t)row * 32); float s = 0.f;
#pragma unroll
    for (int j = 0; j < 8; ++j) { const f32x4 a = p[j]; s += (a[0] + a[1]) + (a[2] + a[3]); }
    return frsq(s * (1.0f / D) + NORM_EPS);
}
DEV void rstd4_sel(const GAS float* part, const GAS float* parts, int row0, bool sp, float (&rs)[4]) {
    if (!sp) { rstd4_from_part(part, row0, rs); return; }
#pragma unroll
    for (int g = 0; g < 4; ++g) { const int r = row0 + 16 * g; rs[g] = rstd_from_part32(parts, (r < MR ? r : MR - 1) - MP); }
}
struct EpiProj {
    static constexpr bool PERM = true;
    GAS bf16* proj; const GAS float* part; const GAS float* parts;
    DEV void operator()(const f32x4 (&acc)[2][2][4][2], const pg8::Unit& u, int wr, int wc, int fr, int fq) const {
        const bool sp = u.pm * 256 >= MP;
#pragma unroll
        for (int ai = 0; ai < 2; ++ai) { const int row0 = u.pm * 256 + ai * 128 + wr * 64 + fr; if (sp && row0 - fr >= MR) continue;
            float rs[4]; rstd4_sel(part, parts, row0, sp, rs);
#pragma unroll
            for (int m = 0; m < 4; ++m) { const int row = row0 + m * 16; if (sp && row >= MR) continue;
#pragma unroll
                for (int bj = 0; bj < 2; ++bj) { const int col0 = u.pn * 256 + bj * 128 + wc * 32 + 8 * fq;
                    if (col0 < IN_PROJ) { const u32x2 a = pk4(acc[ai][bj][m][0] * rs[m]), b = pk4(acc[ai][bj][m][1] * rs[m]); u32x4 w; w.x = a.x; w.y = a.y; w.z = b.x; w.w = b.y;
                        *(GAS u32x4*)(proj + (size_t)row * IN_PROJ + col0) = w; } } } }
    }
};
template <bool F32OUT> struct EpiResid {
    static constexpr bool PERM = true;
    GAS float* xout; GAS bf16* xb; GAS float* part;
    DEV void operator()(const f32x4 (&acc)[2][2][4][2], const pg8::Unit& u, int wr, int wc, int fr, int fq) const {
#pragma unroll
        for (int ai = 0; ai < 2; ++ai) { const int row0 = u.pm * 256 + ai * 128 + wr * 64 + fr; u32x4 xo[4][2];
#pragma unroll
            for (int m = 0; m < 4; ++m)
#pragma unroll
                for (int bj = 0; bj < 2; ++bj) xo[m][bj] = *(const GAS u32x4*)(xb + (size_t)(row0 + 16 * m) * D + u.pn * 256 + bj * 128 + wc * 32 + 8 * fq);
#pragma unroll
            for (int m = 0; m < 4; ++m) { const int row = row0 + 16 * m; float ss = 0.f;
#pragma unroll
                for (int bj = 0; bj < 2; ++bj) { const size_t o = (size_t)row * D + u.pn * 256 + bj * 128 + wc * 32 + 8 * fq;
                    f32x4 x0 = up4((u32x2){xo[m][bj].x, xo[m][bj].y}) + acc[ai][bj][m][0], x1 = up4((u32x2){xo[m][bj].z, xo[m][bj].w}) + acc[ai][bj][m][1];
                    if (F32OUT) { *(GAS f32x4*)(xout + o) = x0; *(GAS f32x4*)(xout + o + 4) = x1; }
                    const u32x2 a = pk4(x0), b = pk4(x1); u32x4 w; w.x = a.x; w.y = a.y; w.z = b.x; w.w = b.y; *(GAS u32x4*)(xb + o) = w;
                    x0 = up4(a); x1 = up4(b);
                    ss += (x0[0] * x0[0] + x0[1] * x0[1]) + (x0[2] * x0[2] + x0[3] * x0[3]) + (x1[0] * x1[0] + x1[1] * x1[1]) + (x1[2] * x1[2] + x1[3] * x1[3]); }
                ss += SHFLX(ss, 16); ss += SHFLX(ss, 32);
                if (fq == 0) part[(size_t)row * 16 + u.pn * 4 + wc] = ss; } }
    }
};
struct EpiGU {
    static constexpr bool PERM = true;
    GAS bf16* hid; const GAS float* part; const GAS float* parts;
    DEV void operator()(const f32x4 (&acc)[2][2][4][2], const pg8::Unit& u, int wr, int wc, int fr, int fq) const {
        const bool sp = u.pm * 256 >= MP;
#pragma unroll
        for (int ai = 0; ai < 2; ++ai) { const int row0 = u.pm * 256 + ai * 128 + wr * 64 + fr; if (sp && row0 - fr >= MR) continue;
            float rs[4]; rstd4_sel(part, parts, row0, sp, rs);
#pragma unroll
            for (int m = 0; m < 4; ++m) { const int row = row0 + m * 16; if (sp && row >= MR) continue;
#pragma unroll
                for (int bj = 0; bj < 2; ++bj) { const int col0 = u.pn * 256 + bj * 128 + wc * 32 + 8 * fq;
                    *(GAS u32x2*)(hid + (size_t)row * FF + (col0 >> 1)) = swiglu4(acc[ai][bj][m][0], acc[ai][bj][m][1], rs[m] * -1.4426950408889634f, rs[m] * rs[m]); } } }
    }
};

template <class Epi> DEV void skinny_gemm(LAS unsigned char* lds, const GAS bf16* A, const GAS bf16* Bt, int K, int N, const Epi& E, int tid, int nidle) {
    const int nit = (N + 31) / 32, lane = tid & 63, w = tid >> 6, fr = lane & 15, fq = lane >> 4, mp = w & 3, kh = w >> 2, nks = K / 64;
    constexpr int NMT = MS / 16;
    const int nworkers = (nidle > 0 && nidle <= (int)gridDim.x) ? nidle : (int)gridDim.x;
    if ((int)gridDim.x - 1 - (int)blockIdx.x >= nworkers) return;
    for (int it = (int)gridDim.x - 1 - (int)blockIdx.x; it < nit; it += nworkers) {
        f32x4 acc[2][2];
#pragma unroll
        for (int i = 0; i < 2; ++i)
#pragma unroll
            for (int j = 0; j < 2; ++j) acc[i][j] = (f32x4){0.f, 0.f, 0.f, 0.f};
        const int m0 = (2 * mp < NMT) ? 2 * mp : 0, m1 = (2 * mp + 1 < NMT) ? 2 * mp + 1 : m0;
        const GAS bf16* ap0 = A + (size_t)(16 * m0 + fr) * K + kh * (K / 2) + 8 * fq; const GAS bf16* ap1 = A + (size_t)(16 * m1 + fr) * K + kh * (K / 2) + 8 * fq;
        const GAS bf16* bp0 = Bt + (size_t)(32 * it + fr) * K + kh * (K / 2) + 8 * fq; const GAS bf16* bp1 = bp0 + (size_t)16 * K;
        for (int kb = 0; kb < nks; kb += 4) {
            bf16x8 a0[4], a1[4], b0[4], b1[4];
#pragma unroll
            for (int s = 0; s < 4; ++s) { a0[s] = *(const GAS bf16x8*)(ap0 + 32 * (kb + s)); a1[s] = *(const GAS bf16x8*)(ap1 + 32 * (kb + s)); b0[s] = *(const GAS bf16x8*)(bp0 + 32 * (kb + s)); b1[s] = *(const GAS bf16x8*)(bp1 + 32 * (kb + s)); }
#pragma unroll
            for (int s = 0; s < 4; ++s) { acc[0][0] = MFMA16(b0[s], a0[s], acc[0][0]); acc[0][1] = MFMA16(b1[s], a0[s], acc[0][1]); acc[1][0] = MFMA16(b0[s], a1[s], acc[1][0]); acc[1][1] = MFMA16(b1[s], a1[s], acc[1][1]); }
        }
        if (kh == 1) {
#pragma unroll
            for (int i = 0; i < 2; ++i)
#pragma unroll
                for (int j = 0; j < 2; ++j) *(LAS f32x4*)(lds + ((mp * 4 + i * 2 + j) * 64 + lane) * 16) = acc[i][j]; }
        __syncthreads();
        if (kh == 0) {
#pragma unroll
            for (int i = 0; i < 2; ++i) {
#pragma unroll
                for (int j = 0; j < 2; ++j) acc[i][j] += *(const LAS f32x4*)(lds + ((mp * 4 + i * 2 + j) * 64 + lane) * 16);
                if (2 * mp + i < NMT) E(acc[i], 16 * (2 * mp + i) + fr, 32 * it + 4 * fq, fq); } }
        __syncthreads();
    }
}
template <int K, class Epi> DEV void skinny_gemm_k8(LAS unsigned char* lds, const GAS bf16* A, const GAS bf16* Bt, int N, const Epi& E, int tid) {
    constexpr int NMT = MS / 16, KS = K / 8, NK = KS / 32; static_assert(KS % 32 == 0, "K/8 must be a multiple of 32");
    const int ncg = N / 32, nit = NMT * ncg, lane = tid & 63, w = tid >> 6, fr = lane & 15, fq = lane >> 4;
    for (int it = (int)gridDim.x - 1 - (int)blockIdx.x; it < nit; it += (int)gridDim.x) {
        const int mt = it % NMT, cgp = it / NMT;
        const GAS bf16* ap = A + (size_t)(16 * mt + fr) * K + w * KS + 8 * fq; const GAS bf16* bp0 = Bt + (size_t)(32 * cgp + fr) * K + w * KS + 8 * fq; const GAS bf16* bp1 = bp0 + (size_t)16 * K;
        bf16x8 a[NK], b0[NK], b1[NK];
#pragma unroll
        for (int s = 0; s < NK; ++s) { a[s] = *(const GAS bf16x8*)(ap + 32 * s); b0[s] = *(const GAS bf16x8*)(bp0 + 32 * s); b1[s] = *(const GAS bf16x8*)(bp1 + 32 * s); }
        f32x4 acc[2] = {(f32x4){0.f, 0.f, 0.f, 0.f}, (f32x4){0.f, 0.f, 0.f, 0.f}};
#pragma unroll
        for (int s = 0; s < NK; ++s) { acc[0] = MFMA16(b0[s], a[s], acc[0]); acc[1] = MFMA16(b1[s], a[s], acc[1]); }
        if (w > 0) { *(LAS f32x4*)(lds + ((w * 2 + 0) * 64 + lane) * 16) = acc[0]; *(LAS f32x4*)(lds + ((w * 2 + 1) * 64 + lane) * 16) = acc[1]; }
        __syncthreads();
        if (w == 0) {
#pragma unroll
            for (int ww = 1; ww < 8; ++ww) { acc[0] += *(const LAS f32x4*)(lds + ((ww * 2 + 0) * 64 + lane) * 16); acc[1] += *(const LAS f32x4*)(lds + ((ww * 2 + 1) * 64 + lane) * 16); }
            E(acc, 16 * mt + fr, 32 * cgp + 4 * fq, fq); }
        __syncthreads();
    }
}
struct SkProj { GAS bf16* proj; const GAS float* part;
    DEV void operator()(const f32x4 (&acc)[2], int row, int col0, int fq) const { const float rs = rstd_from_part32(part, row);
#pragma unroll
        for (int nt = 0; nt < 2; ++nt) { const int c = col0 + 16 * nt; if (c < IN_PROJ) *(GAS u32x2*)(proj + (size_t)row * IN_PROJ + c) = pk4(acc[nt] * rs); } } };
template <bool F32OUT> struct SkResid { GAS float* xout; GAS bf16* xb; GAS float* part;
    DEV void operator()(const f32x4 (&acc)[2], int row, int col0, int fq) const { float ss = 0.f;
#pragma unroll
        for (int nt = 0; nt < 2; ++nt) { const size_t o = (size_t)row * D + col0 + 16 * nt; f32x4 x = up4(*(const GAS u32x2*)(xb + o)) + acc[nt];
            if (F32OUT) *(GAS f32x4*)(xout + o) = x;
            const u32x2 pk = pk4(x); *(GAS u32x2*)(xb + o) = pk; x = up4(pk);
            ss += (x[0] * x[0] + x[1] * x[1]) + (x[2] * x[2] + x[3] * x[3]); }
        ss += SHFLX(ss, 16); ss += SHFLX(ss, 32);
        if (fq == 0) part[(size_t)row * 32 + (col0 >> 5)] = ss; } };
struct SkGU { GAS bf16* hid; const GAS float* part;
    DEV void operator()(const f32x4 (&acc)[2], int row, int col0, int fq) const { const float rs = rstd_from_part32(part, row);
#pragma unroll
        for (int nt = 0; nt < 2; ++nt) { const f32x4 a = acc[nt] * rs; *(GAS unsigned*)(hid + (size_t)row * FF + ((col0 + 16 * nt) >> 1)) = pk2(siluf_(a[0]) * a[1], siluf_(a[2]) * a[3]); } } };

constexpr int NWAVES = 8, LDS_BYTES = 147456, MISC_OFF = 131072 + 320;
struct Args { const float* in[N_IN]; float* out; unsigned char* ws; int ph_lo, ph_hi; };
struct Ctx {
    const float* const* in; float* out; unsigned char* ws; LAS unsigned char* lds; int tid, lane, wave, G, bid, qsel;
};
#define WSP(T, off) ((GAS T*)(C.ws + (off)))
#define GIN(i) ((const GAS float*)C.in[i])
#define GOUT ((GAS float*)C.out)

#if !defined(HOST_EMU)
#define XB_TMO      128
#define XB_XCNT(j)  (256  + 64 * (j))
#define XB_XSUB(j)  (1280 + 64 * (j))
#define XB_XGEN(j)  (2304 + 64 * (j))
#define XB_TOP      3328
#define XB_TOPGEN   3392
#define XCD_BAR_WORDS 3456
#define XB_SPIN_CAP (1u << 22)
__device__ __forceinline__ unsigned xb_ld(unsigned* p)              { return __hip_atomic_load(p, __ATOMIC_RELAXED, __HIP_MEMORY_SCOPE_AGENT); }
__device__ __forceinline__ unsigned xb_add(unsigned* p, unsigned v) { return __hip_atomic_fetch_add(p, v, __ATOMIC_RELAXED, __HIP_MEMORY_SCOPE_AGENT); }
__device__ __forceinline__ unsigned xb_xcc_id() { return (unsigned)__builtin_amdgcn_s_getreg((3 << 11) | 20) & 0xFu; }
#define XB_SPIN(cond, bar) do { unsigned _sp = 0; while (cond) { __builtin_amdgcn_s_sleep(1); \
    if ((++_sp & 255u) == 0u) { if (xb_ld(&(bar)[XB_TMO])) break; if (_sp > XB_SPIN_CAP) { atomicAdd(&(bar)[XB_TMO], 1u); break; } } } } while (0)
struct XcdBarrier { unsigned* bar; unsigned x; volatile LAS unsigned* st; };
__device__ __forceinline__ XcdBarrier xcd_barrier_post(unsigned* bar, volatile LAS unsigned* st) {
    XcdBarrier b; b.bar = bar; b.x = xb_xcc_id(); b.st = st;
    if (threadIdx.x == 0) (void)xb_add(&bar[XB_XCNT(b.x)], 1u);
    return b;
}
__device__ __forceinline__ void xcd_barrier_complete(unsigned* bar, unsigned x, unsigned& nloc, unsigned& nx) {
    const unsigned G = gridDim.x * gridDim.y * gridDim.z;
    unsigned sum, cnt, mine, sp = 0u;
    for (;;) {
        sum = 0u; cnt = 0u; mine = 0u;
#pragma unroll
        for (unsigned j = 0; j < 16; ++j) { const unsigned c = xb_ld(&bar[XB_XCNT(j)]); sum += c; cnt += (c > 0u) ? 1u : 0u; mine = (j == x) ? c : mine; }
        if (sum == G) break;
        __builtin_amdgcn_s_sleep(1);
        if ((++sp & 255u) == 0u) { if (xb_ld(&bar[XB_TMO])) break; if (sp > XB_SPIN_CAP) { atomicAdd(&bar[XB_TMO], 1u); break; } }
    }
    nloc = mine > 0u ? mine : 1u; nx = cnt > 0u ? cnt : 1u;
}
__device__ __forceinline__ void xcd_barrier(const XcdBarrier& b) {
    asm volatile("s_waitcnt vmcnt(0)" ::: "memory");
    __syncthreads();
    if (threadIdx.x == 0) {
        unsigned* bar = b.bar;
        __builtin_amdgcn_s_waitcnt(0);
        unsigned nloc = b.st[0], nx = b.st[1];
        if (nloc == 0u) { xcd_barrier_complete(bar, b.x, nloc, nx); b.st[0] = nloc; b.st[1] = nx; }
        const unsigned old = xb_add(&bar[XB_XSUB(b.x)], 1u);
        const unsigned gen = old / nloc;
        if (old + 1u == (gen + 1u) * nloc) {
            __builtin_amdgcn_fence(__ATOMIC_RELEASE, "agent");
            asm volatile("s_waitcnt vmcnt(0)" ::: "memory");
            const unsigned og = xb_add(&bar[XB_TOP], 1u);
            const unsigned tg = og / nx;
            if (og + 1u == (tg + 1u) * nx) xb_add(&bar[XB_TOPGEN], 1u);
            else XB_SPIN(xb_ld(&bar[XB_TOPGEN]) == tg, bar);
            __builtin_amdgcn_fence(__ATOMIC_ACQUIRE, "agent");
            xb_add(&bar[XB_XGEN(b.x)], 1u);
            asm volatile("s_waitcnt vmcnt(0)" ::: "memory");
        } else {
            XB_SPIN(xb_ld(&bar[XB_XGEN(b.x)]) == gen, bar);
            __builtin_amdgcn_fence(__ATOMIC_ACQUIRE, "agent");
            asm volatile("s_waitcnt vmcnt(0)" ::: "memory");
        }
    }
    __syncthreads();
}
#endif

template <int TN> DEV void p0_transpose_tile(const GAS float* W, int K, int N, GAS bf16* WT, int rmul, int radd, const GAS float* scale, LAS float* scr, int item, int tid) {
#if !defined(HOST_EMU)
    asm volatile("" : "+v"(tid));
#endif
    constexpr int Q = TN / 4, P = TN + 1; const int nblk = N / TN, kb = item / nblk, nb = item % nblk, k0 = 64 * kb, n0 = TN * nb;
    constexpr int NJ = (16 * TN + 511) / 512; f32x4 v[NJ]; float sc[NJ];
#pragma unroll
    for (int j = 0; j < NJ; ++j) { const int idx = tid + 512 * j; v[j] = (f32x4){0.f, 0.f, 0.f, 0.f}; sc[j] = 1.0f;
        if (idx < 16 * TN) { const int kk = idx / Q, n4 = idx % Q; v[j] = NT_LD((const GAS f32x4*)(W + (size_t)(k0 + kk) * N + n0 + 4 * n4)); if (scale) sc[j] = scale[k0 + kk]; } }
#pragma unroll
    for (int j = 0; j < NJ; ++j) { const int idx = tid + 512 * j;
        if (idx < 16 * TN) { const int kk = idx / Q, n4 = idx % Q; const f32x4 x = v[j] * sc[j];
#pragma unroll
            for (int e_ = 0; e_ < 4; ++e_) scr[kk * P + 4 * n4 + e_] = x[e_]; } }
    __syncthreads();
#pragma unroll
    for (int j = 0; j < (8 * TN + 511) / 512; ++j) { const int pc = tid + 512 * j;
        if (pc < 8 * TN) { const int n = pc >> 3, c = pc & 7; const LAS float* s = scr + (8 * c) * P + n;
            u32x4 o; o.x = pk2(s[0 * P], s[1 * P]); o.y = pk2(s[2 * P], s[3 * P]); o.z = pk2(s[4 * P], s[5 * P]); o.w = pk2(s[6 * P], s[7 * P]);
            *(GAS u32x4*)(WT + (size_t)(rmul * (n0 + n) + radd) * K + k0 + 8 * c) = o; } }
    __syncthreads();
}
DEV void p0_row(const GAS float* xrow, GAS bf16* orow, GAS float* part, int npart, int lane) {
    const GAS f32x4* xr = (const GAS f32x4*)xrow + lane; float s = 0.f;
#pragma unroll
    for (int j = 0; j < 4; ++j) { const f32x4 v = NT_LD(xr + 64 * j); s += (v[0] * v[0] + v[1] * v[1]) + (v[2] * v[2] + v[3] * v[3]); ((GAS u32x2*)orow)[lane + 64 * j] = pk4(v); }
    s = wave_sum(s);
    if (lane < npart) part[lane] = (lane == 0) ? s : 0.f;
}
DEV void phase_prologue(const Ctx& C) {
    LAS float* scr = (LAS float*)C.lds;
    const int gw = C.bid * NWAVES + C.wave, NGW = C.G * NWAVES, lane = C.lane;
    constexpr int I_IN = (D / 64) * (IN_PROJ / 288), I_OUT = (D / 64) * (D / 256), I_G = (D / 64) * (FF / 256), I_DN = (FF / 64) * (D / 256), I_L = I_IN + I_OUT + 2 * I_G + I_DN;
    static_assert(IN_PROJ % 288 == 0 && FF % 256 == 0 && D % 256 == 0, "transpose tile widths");
    for (int it = C.bid; it < DEPTH * I_L; it += C.G) {
        const int l = it / I_L; int r = it % I_L;
        if (r < I_IN) { p0_transpose_tile<288>(GIN(I_WIN) + (size_t)l * D * IN_PROJ, D, IN_PROJ, WSP(bf16, WS_WIN) + (size_t)l * INP * D, 1, 0, GIN(I_ANORM) + l * D, scr, r, C.tid); continue; } r -= I_IN;
        if (r < I_OUT) { p0_transpose_tile<256>(GIN(I_WOUT) + (size_t)l * D * D, D, D, WSP(bf16, WS_WOUT) + (size_t)l * D * D, 1, 0, nullptr, scr, r, C.tid); continue; } r -= I_OUT;
        if (r < I_G) { p0_transpose_tile<256>(GIN(I_WGATE) + (size_t)l * D * FF, D, FF, WSP(bf16, WS_WGU) + (size_t)l * GU * D, 2, 0, GIN(I_FNORM) + l * D, scr, r, C.tid); continue; } r -= I_G;
        if (r < I_G) { p0_transpose_tile<256>(GIN(I_WUP) + (size_t)l * D * FF, D, FF, WSP(bf16, WS_WGU) + (size_t)l * GU * D, 2, 1, GIN(I_FNORM) + l * D, scr, r, C.tid); continue; } r -= I_G;
        p0_transpose_tile<256>(GIN(I_WDOWN) + (size_t)l * FF * D, FF, D, WSP(bf16, WS_WDN) + (size_t)l * D * FF, 1, 0, nullptr, scr, r, C.tid);
    }
    const int gt = C.bid * 512 + C.tid, NT = C.G * 512;
    constexpr int PADV = (INP - IN_PROJ) * D / 8;
    for (int i = gt; i < DEPTH * PADV; i += NT) { const int l = i / PADV, r = i % PADV;
        ((GAS u32x4*)(WSP(bf16, WS_WIN) + (size_t)l * INP * D + (size_t)IN_PROJ * D))[r] = (u32x4){0u, 0u, 0u, 0u}; }
    for (int i = gt; i < DEPTH * 512 * 64; i += NT) { const int l = i / (512 * 64), r = i % (512 * 64), n = r / 64, k = r % 64;
        WSP(bf16, WS_WLD)[i] = (bf16)f2bf(GIN(I_WDEC)[(size_t)l * 64 * 512 + k * 512 + n]); WSP(bf16, WS_WLA)[i] = (bf16)f2bf(GIN(I_WA)[(size_t)l * 64 * 512 + k * 512 + n]); }
    for (int i = gt; i < DEPTH * 512 * 160; i += NT) { const int l = i / (512 * 160), r = i % (512 * 160), n = r / 160, k = r % 160;
        WSP(bf16, WS_WLG)[i] = (bf16)f2bf(GIN(I_WG)[(size_t)l * 160 * 512 + k * 512 + n]); }
    for (int i = gt; i < (SEQ + 1) * 32; i += NT) { const int p = i / 32, f = i % 32; const int pos = (p == SEQ) ? PAST_LEN : p;
        const float inv = exp2f(-(float)f * (13.287712379549449f / 32.0f)); const float ang = (float)pos * inv;
        WSP(float, WS_ROPE)[p * 64 + f] = cosf(ang); WSP(float, WS_ROPE)[p * 64 + 32 + f] = sinf(ang); }
    for (int m = gw; m < MR; m += 2 * NGW) { const int m2 = (m + NGW < MR) ? m + NGW : m;
        const GAS f32x4* xa = (const GAS f32x4*)((m < MP) ? GIN(I_XP) + (size_t)m * D : GIN(I_XS) + (size_t)(m - MP) * D) + lane;
        const GAS f32x4* xc = (const GAS f32x4*)((m2 < MP) ? GIN(I_XP) + (size_t)m2 * D : GIN(I_XS) + (size_t)(m2 - MP) * D) + lane;
        f32x4 va[4], vc[4];
#pragma unroll
        for (int j = 0; j < 4; ++j) { va[j] = xa[64 * j]; vc[j] = xc[64 * j]; }
        float sa = 0.f, sc = 0.f;
#pragma unroll
        for (int j = 0; j < 4; ++j) { sa += (va[j][0] * va[j][0] + va[j][1] * va[j][1]) + (va[j][2] * va[j][2] + va[j][3] * va[j][3]); sc += (vc[j][0] * vc[j][0] + vc[j][1] * vc[j][1]) + (vc[j][2] * vc[j][2] + vc[j][3] * vc[j][3]);
            ((GAS u32x2*)(WSP(bf16, WS_XB) + (size_t)m * D))[lane + 64 * j] = pk4(va[j]); if (m2 != m) ((GAS u32x2*)(WSP(bf16, WS_XB) + (size_t)m2 * D))[lane + 64 * j] = pk4(vc[j]); }
        sa = wave_sum(sa); sc = wave_sum(sc);
        { GAS float* pp = (m < MP) ? WSP(float, WS_PART) + (size_t)m * 16 : WSP(float, WS_PARTS) + (size_t)(m - MP) * 32; const int np = (m < MP) ? 16 : 32; if (lane < np) pp[lane] = (lane == 0) ? sa : 0.f; }
        if (m2 != m) { GAS float* pp = (m2 < MP) ? WSP(float, WS_PART) + (size_t)m2 * 16 : WSP(float, WS_PARTS) + (size_t)(m2 - MP) * 32; const int np = (m2 < MP) ? 16 : 32; if (lane < np) pp[lane] = (lane == 0) ? sc : 0.f; } }
}

constexpr int PB = 144, AR = 64 * PB;
constexpr int O_RT = 0, O_AT = AR, O_BH = 2 * AR, O_KH = 3 * AR, O_ATT = 4 * AR, O_VT = 5 * AR, O_BTT = 6 * AR, O_KTT = 7 * AR;
constexpr int PG = 336, O_LW = 0, O_LA = AR, O_WD = 2 * AR, O_WA = 3 * AR, O_LG = 4 * AR, O_WG = O_LG + 64 * PG;
constexpr int O_Y = 81920, O_WPRE = O_Y, O_APRE = O_Y + 16384, O_AAB = O_Y, O_AAK = O_Y + AR, O_ARB = O_Y + 2 * AR, O_ARK = O_Y + 3 * AR;
constexpr int O_ZT = O_BH, O_DB = O_Y + 4 * AR, O_CS = O_DB + 2048, R2_END = O_CS + 2048;
static_assert(O_WG + 64 * PG <= O_Y && R2_END <= 131072, "R2 LDS map");
DEV bf16x8 ldfrag(const LAS unsigned char* base, int row, int ks, int fq) { return *(const LAS bf16x8*)(base + row * PB + (32 * ks + 8 * fq) * 2); }
DEV bf16x8 ldfragG(const LAS unsigned char* base, int row, int ks, int fq) { return *(const LAS bf16x8*)(base + row * PG + (32 * ks + 8 * fq) * 2); }
DEV int tsw(int row, int tok) { return row * PB + ((((tok >> 3) ^ (row >> 3)) & 7) << 4) + ((tok & 7) << 1); }
DEV bf16x8 ldfragS(const LAS unsigned char* base, int row, int ks, int fq, bool swz) { return *(const LAS bf16x8*)(base + row * PB + ((((4 * ks + fq) ^ (swz ? (row >> 3) : 0)) & 7) << 4)); }
DEV u32x2 ld4(const LAS unsigned char* base, int row, int col) { return *(const LAS u32x2*)(base + row * PB + col * 2); }
DEV void st4(LAS unsigned char* base, int row, int col, u32x2 v) { *(LAS u32x2*)(base + row * PB + col * 2) = v; }
DEV void st1(LAS unsigned char* base, int row, int col, float v) { *(LAS bf16*)(base + row * PB + col * 2) = (bf16)f2bf(v); }

DEV void rwkv_prep_item(const Ctx& C, int l, int item, u32x4 (&lc)[5], bool first) {
#if !defined(HOST_EMU)
    asm volatile("" : "+v"(item));
#endif
    const int h = item & 7, c = (item >> 3) % NCH, b = (item >> 3) / NCH;
    int tid = C.tid;
#if !defined(HOST_EMU)
    asm volatile("" : "+v"(tid));
#endif
    const int lane = tid & 63, w = __builtin_amdgcn_readfirstlane(tid >> 6), fr = lane & 15, fq = lane >> 4;
    LAS unsigned char* L = C.lds;
    const GAS bf16* proj = WSP(bf16, WS_PROJ); const int row0 = b * SEQ + 64 * c;
    const GAS float* mu = GIN(I_MU) + (size_t)l * A_PROJ;
    const int t = tid >> 3, cg = tid & 7;
    float r_[8], k_[8], v_[8];
#ifdef REPMASK
    for (int rep_ = 0; rep_ < ((REPMASK >> 0) & 1) + 1; ++rep_) { asm volatile("" ::: "memory");
#else
    {
#endif
    {
        struct Raw8 { u32x4 a, p; f32x4 m0, m1; };
#define XS8_LD(R, rowi, hpv, col) do { const GAS bf16* pr_ = proj + (size_t)(rowi) * IN_PROJ + (col); R.a = *(const GAS u32x4*)pr_; R.p = (u32x4){0u, 0u, 0u, 0u}; if (hpv) R.p = *(const GAS u32x4*)(pr_ - IN_PROJ); \
            R.m0 = *(const GAS f32x4*)(mu + (col)); R.m1 = *(const GAS f32x4*)(mu + (col) + 4); } while (0)
#define XS8_CV(dst, R) do { _Pragma("unroll") for (int j_ = 0; j_ < 4; ++j_) { const f32x2 a_ = {bf2f(R.a[j_]), bf2f(R.a[j_] >> 16)}, p_ = {bf2f(R.p[j_]), bf2f(R.p[j_] >> 16)}; \
            const f32x2 m_ = (j_ < 2) ? (f32x2){R.m0[2 * j_], R.m0[2 * j_ + 1]} : (f32x2){R.m1[2 * j_ - 4], R.m1[2 * j_ - 3]}; const f32x2 x_ = a_ + m_ * (p_ - a_); dst[2 * j_] = x_.x; dst[2 * j_ + 1] = x_.y; } } while (0)
        const bool hp = (64 * c + t) > 0;
        Raw8 rr, rk, rv, rl[5];
        XS8_LD(rr, row0 + t, hp, h * 64 + 8 * cg); XS8_LD(rk, row0 + t, hp, 512 + h * 64 + 8 * cg); XS8_LD(rv, row0 + t, hp, 1024 + h * 64 + 8 * cg);
        if (first) {
#pragma unroll
            for (int j = 0; j < 5; ++j) { const int idx = tid + 512 * j; if (idx < 64 * 36) { const int tt = idx / 36, ch = idx % 36; XS8_LD(rl[j], row0 + tt, (64 * c + tt) > 0, 1536 + 8 * ch); } } }
        const u32x4 wdv = *(const GAS u32x4*)(WSP(bf16, WS_WLD) + ((size_t)l * 512 + h * 64 + (tid >> 3)) * 64 + (tid & 7) * 8), wav = *(const GAS u32x4*)(WSP(bf16, WS_WLA) + ((size_t)l * 512 + h * 64 + (tid >> 3)) * 64 + (tid & 7) * 8);
        u32x4 wgv[3];
#pragma unroll
        for (int j = 0; j < 3; ++j) { const int idx = tid + 512 * j; if (idx < 64 * 20) wgv[j] = *(const GAS u32x4*)(WSP(bf16, WS_WLG) + ((size_t)l * 512 + h * 64 + idx / 20) * 160 + (idx % 20) * 8); }
        XS8_CV(r_, rr); XS8_CV(k_, rk); XS8_CV(v_, rv);
        if (first) {
#pragma unroll
            for (int j = 0; j < 5; ++j) { const int idx = tid + 512 * j;
                if (idx < 64 * 36) { const int ch = idx % 36; float x[8]; XS8_CV(x, rl[j]);
                    if (ch < 8) {
#pragma unroll
                        for (int e = 0; e < 8; ++e) x[e] = tanhf_(x[e]); }
                    else if (ch >= 16) {
#pragma unroll
                        for (int e = 0; e < 8; ++e) x[e] = sigmoidf_(x[e]); }
                    u32x4 o; o.x = pk2(x[0], x[1]); o.y = pk2(x[2], x[3]); o.z = pk2(x[4], x[5]); o.w = pk2(x[6], x[7]); lc[j] = o; } } }
#pragma unroll
        for (int j = 0; j < 5; ++j) { const int idx = tid + 512 * j;
            if (idx < 64 * 36) { const int tt = idx / 36, ch = idx % 36;
                LAS unsigned char* dst = (ch < 8) ? L + O_LW + tt * PB + ch * 16 : (ch < 16) ? L + O_LA + tt * PB + (ch - 8) * 16 : L + O_LG + tt * PG + (ch - 16) * 16;
                *(LAS u32x4*)dst = lc[j]; } }
#undef XS8_LD
#undef XS8_CV
        *(LAS u32x4*)(L + O_WD + (tid >> 3) * PB + (tid & 7) * 16) = wdv; *(LAS u32x4*)(L + O_WA + (tid >> 3) * PB + (tid & 7) * 16) = wav;
#pragma unroll
        for (int j = 0; j < 3; ++j) { const int idx = tid + 512 * j; if (idx < 64 * 20) *(LAS u32x4*)(L + O_WG + (idx / 20) * PG + (idx % 20) * 16) = wgv[j]; }
    }
    }
    __syncthreads();
#ifdef REPMASK
    for (int rep_ = 0; rep_ < ((REPMASK >> 1) & 1) + 1; ++rep_) { asm volatile("" ::: "memory");
#else
    {
#endif
#pragma unroll
    for (int q = 0; q < 2; ++q) { const int id = 2 * w + q, mt = id >> 2, nt = id & 3;
        f32x4 aw = {0.f, 0.f, 0.f, 0.f}, aa = {0.f, 0.f, 0.f, 0.f}, ag = {0.f, 0.f, 0.f, 0.f};
#pragma unroll
        for (int ks = 0; ks < 2; ++ks) { aw = MFMA16(ldfrag(L + O_WD, 16 * mt + fr, ks, fq), ldfrag(L + O_LW, 16 * nt + fr, ks, fq), aw);
                                         aa = MFMA16(ldfrag(L + O_WA, 16 * mt + fr, ks, fq), ldfrag(L + O_LA, 16 * nt + fr, ks, fq), aa); }
#pragma unroll
        for (int ks = 0; ks < 5; ++ks) ag = MFMA16(ldfragG(L + O_WG, 16 * mt + fr, ks, fq), ldfragG(L + O_LG, 16 * nt + fr, ks, fq), ag);
        const int tok = 16 * nt + fr, ch0 = 16 * mt + 4 * fq;
        *(LAS f32x4*)(L + O_WPRE + (tok * 64 + ch0) * 4) = aw; *(LAS f32x4*)(L + O_APRE + (tok * 64 + ch0) * 4) = aa;
        *(GAS u32x2*)(WSP(bf16, WS_G) + (size_t)(row0 + tok) * 512 + h * 64 + ch0) = pk4(ag); }
    }
    __syncthreads();
    float ld_[8], g_[8], av_[8], bv_[8], km_[8];
#ifdef REPMASK
    for (int rep_ = 0; rep_ < ((REPMASK >> 2) & 1) + 1; ++rep_) { asm volatile("" ::: "memory");
#else
    {
#endif
    {
        const int cc = l * 512 + h * 64 + 8 * cg; float wp[8], ap[8], w0v[8], a0v[8], kkv[8], kav[8], rkv[8];
#define LD8G(dst, ptr) do { const f32x4 a_ = *(const GAS f32x4*)(ptr), b_ = *(const GAS f32x4*)((ptr) + 4); _Pragma("unroll") for (int e_ = 0; e_ < 4; ++e_) { dst[e_] = a_[e_]; dst[4 + e_] = b_[e_]; } } while (0)
#define LD8L(dst, off) do { const f32x4 a_ = *(const LAS f32x4*)(L + (off)), b_ = *(const LAS f32x4*)(L + (off) + 16); _Pragma("unroll") for (int e_ = 0; e_ < 4; ++e_) { dst[e_] = a_[e_]; dst[4 + e_] = b_[e_]; } } while (0)
        LD8L(wp, O_WPRE + (t * 64 + 8 * cg) * 4); LD8L(ap, O_APRE + (t * 64 + 8 * cg) * 4);
        LD8G(w0v, GIN(I_W0) + cc); LD8G(a0v, GIN(I_A0) + cc); LD8G(kkv, GIN(I_KK) + cc); LD8G(kav, GIN(I_KA) + cc); LD8G(rkv, GIN(I_RK) + cc);
        float ssq = 0.f, rks = 0.f, as_[8], kk_[8];
#pragma unroll
        for (int e = 0; e < 8; ++e) { const float wl = -softplusf_(-(wp[e] + w0v[e])) - 0.5f; ld_[e] = -fexp(wl); as_[e] = sigmoidf_(a0v[e] + ap[e]);
            kk_[e] = k_[e] * kkv[e]; ssq += kk_[e] * kk_[e]; km_[e] = k_[e] * (1.0f + (as_[e] - 1.0f) * kav[e]); rks += r_[e] * km_[e] * rkv[e]; }
        ssq += SHFLX(ssq, 1); ssq += SHFLX(ssq, 2); ssq += SHFLX(ssq, 4); rks += SHFLX(rks, 1); rks += SHFLX(rks, 2); rks += SHFLX(rks, 4);
        const float inv = frsq(fmaxf(ssq, 1e-24f));
        if (cg == 0) WSP(float, WS_RKR)[(size_t)(row0 + t) * 8 + h] = rks;
#pragma unroll
        for (int e = 0; e < 8; ++e) { const float kkn = kk_[e] * inv; av_[e] = -kkn; bv_[e] = kkn * as_[e]; g_[e] = ld_[e]; }
#pragma unroll
        for (int off = 8; off < 64; off <<= 1) {
#pragma unroll
            for (int e = 0; e < 8; ++e) { const float o_ = SHFL(g_[e], (lane - off) & 63); if (lane >= off) g_[e] += o_; } }
        if (lane >= 56) {
#pragma unroll
            for (int e = 0; e < 8; ++e) *(LAS float*)(L + O_CS + (w * 64 + 8 * cg + e) * 4) = g_[e]; }
    }
    __syncthreads();
    {
        float off[8], g63[8];
#pragma unroll
        for (int e = 0; e < 8; ++e) { off[e] = 0.f; g63[e] = 0.f; }
#pragma unroll
        for (int ww = 0; ww < 8; ++ww) { float v8[8]; LD8L(v8, O_CS + (ww * 64 + 8 * cg) * 4);
#pragma unroll
            for (int e = 0; e < 8; ++e) { g63[e] += v8[e]; if (ww < w) off[e] += v8[e]; } }
        if (tid < 8) {
#pragma unroll
            for (int e = 0; e < 8; ++e) WSP(float, WS_CHG)[(size_t)item * 64 + 8 * cg + e] = fexp(g63[e]); }
        float rt[8], at[8], bh[8], kh[8];
#pragma unroll
        for (int e = 0; e < 8; ++e) { const float g = off[e] + g_[e]; const float eg = fexp(g), egx = fexp(g - ld_[e]), eng = fexp(-g), e63 = fexp(g63[e] - g);
            rt[e] = r_[e] * eg; at[e] = av_[e] * egx; bh[e] = bv_[e] * eng; kh[e] = km_[e] * eng;
            { const int o_ = tsw(8 * cg + e, t);
              const unsigned w1_ = pk2(at[e], v_[e]), w2_ = pk2(bv_[e] * e63, km_[e] * e63);
              *(LAS bf16*)(L + O_ATT + o_) = (bf16)w1_; *(LAS bf16*)(L + O_VT + o_) = (bf16)(w1_ >> 16); *(LAS bf16*)(L + O_BTT + o_) = (bf16)w2_; *(LAS bf16*)(L + O_KTT + o_) = (bf16)(w2_ >> 16); } }
#define ST8(off_, a_) do { u32x4 o_; o_.x = pk2(a_[0], a_[1]); o_.y = pk2(a_[2], a_[3]); o_.z = pk2(a_[4], a_[5]); o_.w = pk2(a_[6], a_[7]); *(LAS u32x4*)(L + (off_) + t * PB + cg * 16) = o_; } while (0)
        ST8(O_RT, rt); ST8(O_AT, at); ST8(O_BH, bh); ST8(O_KH, kh);
#undef ST8
#undef LD8G
#undef LD8L
        if (c == NCH - 1 && h == 0) for (int col = tid; col < A_PROJ; col += 512) GOUT[O_PSH + (size_t)(l * BATCH + b) * A_PROJ + col] = bf2f(proj[(size_t)(b * SEQ + SEQ - 1) * IN_PROJ + col]);
    }
    __syncthreads();
    }
#ifdef REPMASK
    for (int rep_ = 0; rep_ < ((REPMASK >> 3) & 1) + 1; ++rep_) { asm volatile("" ::: "memory");
#else
    {
#endif
    {
        const int p = w >> 1, mtb = 2 * (w & 1); const LAS unsigned char* X = L + ((p < 2) ? O_AT : O_RT); const LAS unsigned char* Y = L + ((p & 1) ? O_KH : O_BH);
        bf16x8 ya[2][2], xb_[4][2];
#pragma unroll
        for (int ks = 0; ks < 2; ++ks) {
#pragma unroll
            for (int i = 0; i < 2; ++i) ya[i][ks] = ldfrag(Y, 16 * (mtb + i) + fr, ks, fq);
#pragma unroll
            for (int nt = 0; nt < 4; ++nt) xb_[nt][ks] = ldfrag(X, 16 * nt + fr, ks, fq); }
#pragma unroll
        for (int i = 0; i < 2; ++i)
#pragma unroll
            for (int nt = 0; nt < 4; ++nt) { const int mt = mtb + i; f32x4 acc = {0.f, 0.f, 0.f, 0.f};
                if (mt <= nt) { acc = MFMA16(ya[i][0], xb_[nt][0], acc); acc = MFMA16(ya[i][1], xb_[nt][1], acc);
                    if (mt == nt) { const int dlt = fr - 4 * fq - ((p < 2) ? 1 : 0);
#pragma unroll
                        for (int e = 0; e < 4; ++e) if (e > dlt) acc[e] = 0.f; } }
                st4(L + O_AAB + p * AR, 16 * nt + fr, 16 * mt + 4 * fq, pk4(acc)); }
    }
    }
    __syncthreads();
#ifdef REPMASK
    for (int rep_ = 0; rep_ < ((REPMASK >> 4) & 1) + 1; ++rep_) { asm volatile("" ::: "memory");
#else
    {
#endif
#pragma unroll
    for (int q = 0; q < 2; ++q) { const int id = 2 * w + q, mt = id >> 2, nt = id & 3; f32x4 acc = {0.f, 0.f, 0.f, 0.f};
#pragma unroll
        for (int ks = 0; ks < 2; ++ks) acc = MFMA16(ldfrag(L + O_AAK, 16 * mt + fr, ks, fq), ldfragS(L + O_VT, 16 * nt + fr, ks, fq, true), acc);
        *(LAS u32x2*)(L + O_ZT + tsw(16 * nt + fr, 16 * mt + 4 * fq)) = pk4(acc); }
    if (w == 7) { const int blk = lane >> 4, cc = lane & 15; float T_[16];
#pragma unroll
        for (int t = 0; t < 16; ++t) { float a = (t == cc) ? 1.0f : 0.0f;
#pragma unroll
            for (int s = 0; s < t; ++s) a += bf2f(*(const LAS bf16*)(L + O_AAB + (16 * blk + t) * PB + (16 * blk + s) * 2)) * T_[s];
            T_[t] = a; *(LAS bf16*)(L + O_DB + blk * 512 + t * 32 + cc * 2) = (bf16)f2bf(a); } }
    }
    __syncthreads();
    {
        LAS unsigned char* arr = L + ((w < 4) ? O_ATT : O_ZT); const int srow = 16 * (w & 3) + fr;
        const u32x2 z2 = {0u, 0u}; f32x4 X[4];
#pragma unroll
        for (int i = 0; i < 4; ++i) {
            f32x4 inner = up4(*(const LAS u32x2*)(arr + tsw(srow, 16 * i + 4 * fq)));
#pragma unroll
            for (int kk = 0; kk < i; kk += 2) {
                const u32x2 blo = pk4(X[kk]), bhi = (kk + 1 < i) ? pk4(X[kk + 1]) : z2;
                const u32x2 alo = ld4(L + O_AAB, 16 * i + fr, 16 * kk + 4 * fq), ahi = (kk + 1 < i) ? ld4(L + O_AAB, 16 * i + fr, 16 * (kk + 1) + 4 * fq) : z2;
                inner = MFMA16(mk8(alo, ahi), mk8(blo, bhi), inner); }
            const u32x2 dlo = *(const LAS u32x2*)(L + O_DB + i * 512 + fr * 32 + 4 * fq * 2);
            X[i] = MFMA16(mk8(dlo, z2), mk8(pk4(inner), z2), ((f32x4){0.f, 0.f, 0.f, 0.f}));
            *(LAS u32x2*)(arr + tsw(srow, 16 * i + 4 * fq)) = pk4(X[i]); }
    }
    __syncthreads();
#ifdef REPMASK
    for (int rep_ = 0; rep_ < ((REPMASK >> 6) & 1) + 1; ++rep_) { asm volatile("" ::: "memory");
#else
    {
#endif
    {
        const int p = w >> 1, mtb = 2 * (w & 1); const bool two = (p & 1) != 0;
        const int oa1 = (p == 0 || p == 2) ? O_ATT : (p == 1 ? O_ZT : O_BTT), ob1 = (p <= 1) ? O_ARB : (p == 2 ? O_BTT : O_ZT), oa2 = (p == 1) ? O_VT : O_KTT, ob2 = (p == 1) ? O_ARK : O_VT;
        bf16x8 a1[2][2], b1[4][2], a2[2][2], b2[4][2];
#pragma unroll
        for (int ks = 0; ks < 2; ++ks) {
#pragma unroll
            for (int i = 0; i < 2; ++i) { a1[i][ks] = ldfragS(L + oa1, 16 * (mtb + i) + fr, ks, fq, true); a2[i][ks] = a1[i][ks]; if (two) a2[i][ks] = ldfragS(L + oa2, 16 * (mtb + i) + fr, ks, fq, true); }
#pragma unroll
            for (int nt = 0; nt < 4; ++nt) { b1[nt][ks] = ldfragS(L + ob1, 16 * nt + fr, ks, fq, p >= 2); b2[nt][ks] = b1[nt][ks]; if (two) b2[nt][ks] = ldfragS(L + ob2, 16 * nt + fr, ks, fq, p >= 2); } }
#pragma unroll
        for (int i = 0; i < 2; ++i)
#pragma unroll
            for (int nt = 0; nt < 4; ++nt) { const int r0 = 16 * (mtb + i) + 4 * fq, cn = 16 * nt + fr; f32x4 acc = {0.f, 0.f, 0.f, 0.f};
                if (p == 0) acc = up4(ld4(L + O_RT, cn, r0));
                acc = MFMA16(a1[i][0], b1[nt][0], acc); acc = MFMA16(a1[i][1], b1[nt][1], acc);
                if (two) { acc = MFMA16(a2[i][0], b2[nt][0], acc); acc = MFMA16(a2[i][1], b2[nt][1], acc); }
                const size_t o = (size_t)item * 4096 + cn * 64 + r0;
                *(GAS u32x2*)((p == 0 ? WSP(bf16, WS_CHP) : p == 1 ? WSP(bf16, WS_CHW) : p == 2 ? WSP(bf16, WS_CHM) : WSP(bf16, WS_CHN)) + o) = pk4(acc); }
    }
    }
    __syncthreads();
}

constexpr int SM_XS = 0, SM_QKV = 7424, SM_TW = 10496, SM_SG = 10752, SM_VR = 11520, SM_VW = SM_VR + 2048, SM_VK = SM_VW + 2048, SM_VA = SM_VK + 2048, SM_VB = SM_VA + 2048,
              SM_QR = SM_VB + 2048, SM_KN = SM_QR + 2048, SM_PL = SM_KN + 512, SM_END = SM_PL + 4096,
              SM_KC = 32768, SM_KCP = 68  , SM_KC_END = SM_KC + 2 * 127 * SM_KCP * 4;
static_assert(SM_END <= SM_KC && SM_KC_END <= 131072, "sample mixer LDS map");
DEV void sample_mix_item(const Ctx& C, int l, int sb, int part) {
#if !defined(HOST_EMU)
    asm volatile("" : "+v"(sb));
#endif
    int tid = C.tid;
#if !defined(HOST_EMU)
    asm volatile("" : "+v"(tid));
#endif
    const int lane = tid & 63, w = tid >> 6; LAS unsigned char* L = C.lds;
    LAS float* XSv = (LAS float*)(L + SM_XS); LAS float* QKV = (LAS float*)(L + SM_QKV); LAS float* TW = (LAS float*)(L + SM_TW); LAS float* SG = (LAS float*)(L + SM_SG);
    LAS float* VR = (LAS float*)(L + SM_VR); LAS float* VW = (LAS float*)(L + SM_VW); LAS float* VK = (LAS float*)(L + SM_VK); LAS float* VA = (LAS float*)(L + SM_VA); LAS float* VB = (LAS float*)(L + SM_VB);
    LAS float* QR = (LAS float*)(L + SM_QR); LAS float* KN = (LAS float*)(L + SM_KN); LAS float* PL = (LAS float*)(L + SM_PL);
    const int row = MP + sb; const GAS bf16* pr = WSP(bf16, WS_PROJ) + (size_t)row * IN_PROJ; const size_t ls = (size_t)l * MS + sb;
    const GAS float* mu = GIN(I_MU) + (size_t)l * A_PROJ;
    f32x4 vv[16];
    if (part == 0) {
        float pa[4], pv[4], mv[4];
#pragma unroll
        for (int j = 0; j < 4; ++j) { const int col = tid + 512 * j; pa[j] = 0.f; pv[j] = 0.f; mv[j] = 0.f; if (col < A_PROJ) { pa[j] = bf2f(pr[col]); pv[j] = GIN(I_SSHIFT)[ls * A_PROJ + col]; mv[j] = mu[col]; } }
#pragma unroll
        for (int j = 0; j < 4; ++j) { const int col = tid + 512 * j; if (col < A_PROJ) { XSv[col] = pa[j] + mv[j] * (pv[j] - pa[j]); GOUT[O_SSH + ls * A_PROJ + col] = pa[j]; } }
    } else {
        const GAS f32x4* kc = (const GAS f32x4*)(GIN(I_CK) + (ls * 128 + 1) * 128); f32x4 kb[8];
#pragma unroll
        for (int j = 0; j < 8; ++j) { const int idx = tid + 512 * j; kb[j] = (f32x4){0.f, 0.f, 0.f, 0.f}; if (idx < 127 * 32) kb[j] = kc[idx]; }
        { const int kg = lane >> 4, dq = lane & 15; const GAS float* vp = GIN(I_CV) + (ls * 128 + 1) * 128 + (w >> 2) * 64 + 4 * dq;
#pragma unroll
          for (int j = 0; j < 16; ++j) { const int u = kg + 4 * j; vv[j] = *(const GAS f32x4*)(vp + (size_t)u * 128); } }
        float pa[2];
#pragma unroll
        for (int j = 0; j < 2; ++j) { const int col = tid + 512 * j; pa[j] = 0.f; if (col < IN_PROJ - A_PROJ) pa[j] = bf2f(pr[A_PROJ + col]); }
#pragma unroll
        for (int j = 0; j < 2; ++j) { const int col = tid + 512 * j; if (col < IN_PROJ - A_PROJ) QKV[col] = pa[j]; }
#pragma unroll
        for (int j = 0; j < 8; ++j) { const int idx = tid + 512 * j, krow = idx >> 5, c = idx & 31; if (idx < 127 * 32) *(LAS f32x4*)(L + SM_KC + (((c >> 4) * 127 + krow) * SM_KCP + 4 * (c & 15)) * 4) = kb[j]; }
    }
    __syncthreads();
    if (part == 0) {
    if (tid < 64) TW[tid] = tanhf_(XSv[1536 + tid]); else if (tid < 224) SG[tid - 64] = sigmoidf_(XSv[1664 + tid - 64]);
    __syncthreads();
    const int ch = tid, cl = l * 512 + ch;
    float wp = GIN(I_W0)[cl], ap = GIN(I_A0)[cl], gg = 0.f;
    {
      const GAS u32x4* Wd = (const GAS u32x4*)(WSP(bf16, WS_WLD) + ((size_t)l * 512 + ch) * 64); const GAS u32x4* Wa = (const GAS u32x4*)(WSP(bf16, WS_WLA) + ((size_t)l * 512 + ch) * 64);
      const GAS u32x4* Wg = (const GAS u32x4*)(WSP(bf16, WS_WLG) + ((size_t)l * 512 + ch) * 160);
      u32x4 wd[8], wa[8], wg[20];
#pragma unroll
      for (int q = 0; q < 8; ++q) { wd[q] = Wd[q]; wa[q] = Wa[q]; }
#pragma unroll
      for (int q = 0; q < 20; ++q) wg[q] = Wg[q];
#pragma unroll
      for (int q = 0; q < 8; ++q) { const f32x4 t0 = *(const LAS f32x4*)(TW + 8 * q), t1 = *(const LAS f32x4*)(TW + 8 * q + 4), x0 = *(const LAS f32x4*)(XSv + 1600 + 8 * q), x1 = *(const LAS f32x4*)(XSv + 1600 + 8 * q + 4);
          const f32x4 d0 = up4((u32x2){wd[q].x, wd[q].y}), d1 = up4((u32x2){wd[q].z, wd[q].w}), a0 = up4((u32x2){wa[q].x, wa[q].y}), a1 = up4((u32x2){wa[q].z, wa[q].w});
          wp += (t0[0] * d0[0] + t0[1] * d0[1]) + (t0[2] * d0[2] + t0[3] * d0[3]) + (t1[0] * d1[0] + t1[1] * d1[1]) + (t1[2] * d1[2] + t1[3] * d1[3]);
          ap += (x0[0] * a0[0] + x0[1] * a0[1]) + (x0[2] * a0[2] + x0[3] * a0[3]) + (x1[0] * a1[0] + x1[1] * a1[1]) + (x1[2] * a1[2] + x1[3] * a1[3]); }
#pragma unroll
      for (int q = 0; q < 20; ++q) { const f32x4 s0 = *(const LAS f32x4*)(SG + 8 * q), s1 = *(const LAS f32x4*)(SG + 8 * q + 4);
          const f32x4 g0 = up4((u32x2){wg[q].x, wg[q].y}), g1 = up4((u32x2){wg[q].z, wg[q].w});
          gg += (s0[0] * g0[0] + s0[1] * g0[1]) + (s0[2] * g0[2] + s0[3] * g0[3]) + (s1[0] * g1[0] + s1[1] * g1[1]) + (s1[2] * g1[2] + s1[3] * g1[3]); } }
    f32x4 t[16];
    { const GAS f32x4* sg0 = (const GAS f32x4*)(GIN(I_SRWKV) + (ls * 8 + w) * 4096);
#pragma unroll
      for (int j = 0; j < 16; ++j) { const int idx = lane + 64 * (j & 7); t[j] = sg0[(idx >> 3) * 16 + 8 * (j >> 3) + (idx & 7)]; } }
    const float wl = -softplusf_(-wp) - 0.5f, dec = fexp(-fexp(wl)), as = sigmoidf_(ap);
    const float r = XSv[ch], k = XSv[512 + ch], v = XSv[1024 + ch];
    const float kk = k * GIN(I_KK)[cl]; const float kkn = kk * frsq(fmaxf(wave_sum(kk * kk), 1e-24f));
    const float km = k * (1.0f + (as - 1.0f) * GIN(I_KA)[cl]); const float rkr = wave_sum(r * km * GIN(I_RK)[cl]);
    VR[ch] = r; VW[ch] = dec; VK[ch] = km; VA[ch] = -kkn; VB[ch] = kkn * as;
    __syncthreads();
    {
        const size_t hb = (ls * 8 + w) * 4096; LAS float* SL = (LAS float*)(L + SM_KC + w * (64 * 36 * 4)); f32x4 S[16];
        {
#pragma unroll
          for (int h2 = 0; h2 < 2; ++h2) {
#pragma unroll
              for (int j = 0; j < 8; ++j) { const int idx = lane + 64 * j; *(LAS f32x4*)(SL + (idx >> 3) * 36 + 4 * (idx & 7)) = t[8 * h2 + j]; }
              WAVE_SYNC();
#pragma unroll
              for (int j = 0; j < 8; ++j) S[8 * h2 + j] = *(const LAS f32x4*)(SL + lane * 36 + 4 * j);
              WAVE_SYNC(); } }
        float sa = 0.f;
#pragma unroll
        for (int j = 0; j < 16; ++j) { const f32x4 a = *(const LAS f32x4*)(VA + 64 * w + 4 * j); sa += (S[j][0] * a[0] + S[j][1] * a[1]) + (S[j][2] * a[2] + S[j][3] * a[3]); }
        float y = 0.f; GAS f32x4* og = (GAS f32x4*)(GOUT + O_SS + hb);
#pragma unroll
        for (int j = 0; j < 16; ++j) { const f32x4 ww = *(const LAS f32x4*)(VW + 64 * w + 4 * j), bb = *(const LAS f32x4*)(VB + 64 * w + 4 * j), kv = *(const LAS f32x4*)(VK + 64 * w + 4 * j), rr = *(const LAS f32x4*)(VR + 64 * w + 4 * j);
            const f32x4 sn = S[j] * ww + sa * bb + v * kv; S[j] = sn; y += (sn[0] * rr[0] + sn[1] * rr[1]) + (sn[2] * rr[2] + sn[3] * rr[3]); }
#pragma unroll
        for (int h2 = 0; h2 < 2; ++h2) {
#pragma unroll
            for (int j = 0; j < 8; ++j) *(LAS f32x4*)(SL + lane * 36 + 4 * j) = S[8 * h2 + j];
            WAVE_SYNC();
#pragma unroll
            for (int j = 0; j < 8; ++j) { const int idx = lane + 64 * j; NT_ST(og + (idx >> 3) * 16 + 8 * h2 + (idx & 7), *(const LAS f32x4*)(SL + (idx >> 3) * 36 + 4 * (idx & 7))); }
            WAVE_SYNC(); }
        const float mean = wave_sum(y) * (1.0f / 64.0f), dd = y - mean, var = wave_sum(dd * dd) * (1.0f / 64.0f);
        const float yn = dd * frsq(var + LNX_EPS) * GIN(I_LNG)[cl] + GIN(I_LNB)[cl];
        WSP(bf16, WS_MIX)[(size_t)row * D + ch] = (bf16)f2bf((yn + rkr * v) * gg);
    }
    } else {
    {
        const int d = lane, dd = d & 31; const float cs = WSP(float, WS_ROPE)[SEQ * 64 + dd], sn = WSP(float, WS_ROPE)[SEQ * 64 + 32 + dd];
        { const float x1 = QKV[w * 64 + dd], x2 = QKV[w * 64 + 32 + dd]; QR[w * 64 + d] = ((d < 32) ? x1 * cs - x2 * sn : x2 * cs + x1 * sn) * 0.125f; }
        if (w < 2) { const float x1 = QKV[512 + w * 64 + dd], x2 = QKV[512 + w * 64 + 32 + dd]; const float kr = (d < 32) ? x1 * cs - x2 * sn : x2 * cs + x1 * sn;
            KN[w * 64 + d] = kr; GOUT[O_SK + (ls * 128 + 127) * 128 + w * 64 + d] = kr; GOUT[O_SV + (ls * 128 + 127) * 128 + w * 64 + d] = QKV[640 + w * 64 + d]; }
    }
    __syncthreads();
    {
        const int hq = w, kvh = hq >> 2; const float sink = GIN(I_SINK)[l * 8 + hq];
        float s[2];
#pragma unroll
        for (int kx = 0; kx < 2; ++kx) { const int u = lane + 64 * kx; float a = 0.f;
            if (u < 127) { const LAS f32x4* kp = (const LAS f32x4*)(L + SM_KC + ((kvh * 127 + u) * SM_KCP) * 4);
#pragma unroll
                for (int j = 0; j < 16; ++j) { const f32x4 kq = kp[j], qq = *(const LAS f32x4*)(QR + hq * 64 + 4 * j); a += (kq[0] * qq[0] + kq[1] * qq[1]) + (kq[2] * qq[2] + kq[3] * qq[3]); } }
            else {
#pragma unroll
                for (int j = 0; j < 16; ++j) { const f32x4 kq = *(const LAS f32x4*)(KN + kvh * 64 + 4 * j), qq = *(const LAS f32x4*)(QR + hq * 64 + 4 * j); a += (kq[0] * qq[0] + kq[1] * qq[1]) + (kq[2] * qq[2] + kq[3] * qq[3]); } }
            s[kx] = a; }
        const float m = fmaxf(wave_max(fmaxf(s[0], s[1])), sink); const float p0 = fexp(s[0] - m), p1 = fexp(s[1] - m);
        const float den = wave_sum(p0 + p1) + fexp(sink - m);
        PL[hq * 128 + lane] = p0; PL[hq * 128 + 64 + lane] = p1;
        WAVE_SYNC();
        const int kg = lane >> 4, dq = lane & 15; f32x4 o = {0.f, 0.f, 0.f, 0.f}; const GAS float* vp = GIN(I_CV) + (ls * 128 + 1) * 128 + kvh * 64 + 4 * dq;
        {
            f32x4 v2[16];
#pragma unroll
            for (int j = 0; j < 16; ++j) { const int u = kg + 4 * (16 + j); v2[j] = (f32x4){0.f, 0.f, 0.f, 0.f}; if (u < 127) v2[j] = *(const GAS f32x4*)(vp + (size_t)u * 128); }
#pragma unroll
            for (int j = 0; j < 16; ++j) { const int u = kg + 4 * j; o += PL[hq * 128 + u] * vv[j]; }
#pragma unroll
            for (int j = 0; j < 16; ++j) { const int u = kg + 4 * (16 + j); o += PL[hq * 128 + (u < 127 ? u : 0)] * v2[j]; } }
        if (kg == 0) o += PL[hq * 128 + 127] * *(const LAS f32x4*)(QKV + 640 + kvh * 64 + 4 * dq);
#pragma unroll
        for (int e = 0; e < 4; ++e) { o[e] += SHFLX(o[e], 16); o[e] += SHFLX(o[e], 32); }
        if (kg == 0) *(GAS u32x2*)(WSP(bf16, WS_MIX) + (size_t)row * D + 512 + hq * 64 + 4 * dq) = pk4(o * (1.0f / den));
    }
    }
    __syncthreads();
}

DEV void cache_shift_item(const Ctx& C, int l, int it) {
    const int sb = it >> 1, kv = it & 1, tid = C.tid; const size_t ls = (size_t)l * MS + sb;
    const GAS f32x4* src = (const GAS f32x4*)((kv ? GIN(I_CV) : GIN(I_CK)) + ls * 16384 + 128); GAS f32x4* dst = (GAS f32x4*)(GOUT + (kv ? O_SV : O_SK) + ls * 16384);
    f32x4 v[8];
#pragma unroll
    for (int j = 0; j < 8; ++j) { const int i = tid + 512 * j; if (i < 127 * 32) v[j] = NT_LD(src + i); }
#pragma unroll
    for (int j = 0; j < 8; ++j) { const int i = tid + 512 * j; if (i < 127 * 32) NT_ST(dst + i, v[j]); }
}

constexpr int SC_MP = 136, SC_NP = 136, SC_M = 0, SC_N = 64 * SC_MP, SC_G = SC_N + 16 * SC_NP, SC_SLOT = SC_G + 256, SC_R = 9, SC_D = 7;
static_assert(SC_SLOT % 16 == 0 && SC_R * SC_SLOT + 128 <= 131072, "scan ring");
struct ScanLd { u32x4 m[8], n[2], g; };
DEV void scan_ld_issue(const Ctx& C, ScanLd& o, int item, int sl, int lane) {
    const GAS u32x4* M = (const GAS u32x4*)(WSP(bf16, WS_CHM) + (size_t)item * 4096); const GAS u32x4* N = (const GAS u32x4*)(WSP(bf16, WS_CHN) + (size_t)item * 4096 + sl * 1024); const GAS u32x4* G = (const GAS u32x4*)(WSP(float, WS_CHG) + (size_t)item * 64);
#pragma unroll
    for (int j = 0; j < 8; ++j) o.m[j] = M[lane + 64 * j];
#pragma unroll
    for (int j = 0; j < 2; ++j) o.n[j] = N[lane + 64 * j];
    o.g = G[lane & 15];
}
DEV void scan_ld_write(const ScanLd& o, LAS unsigned char* slot, int lane) {
#pragma unroll
    for (int j = 0; j < 8; ++j) { const int pc = lane + 64 * j, row = pc >> 3, cc = pc & 7; LAS u32x2* d = (LAS u32x2*)(slot + SC_M + row * SC_MP + cc * 16); d[0] = (u32x2){o.m[j].x, o.m[j].y}; d[1] = (u32x2){o.m[j].z, o.m[j].w}; }
#pragma unroll
    for (int j = 0; j < 2; ++j) { const int pc = lane + 64 * j, row = pc >> 3, cc = pc & 7; LAS u32x2* d = (LAS u32x2*)(slot + SC_N + row * SC_NP + cc * 16); d[0] = (u32x2){o.n[j].x, o.n[j].y}; d[1] = (u32x2){o.n[j].z, o.n[j].w}; }
    if (lane < 16) *(LAS u32x4*)(slot + SC_G + lane * 16) = o.g;
}
constexpr int SC_RDY = SC_R * SC_SLOT, SC_PROG = SC_RDY + 64;
#if defined(HOST_EMU)
#define SPIN_YIELD() emu_yield()
#define EMU_PROGRESS() emu_note_progress()
#else
#define SPIN_YIELD() __builtin_amdgcn_s_sleep(1)
#define EMU_PROGRESS() do {} while (0)
#endif
DEV void rwkv_scan_block(const Ctx& C, int l, int unit) {
    const int sl = unit & 3, h = (unit >> 2) & 7, b = unit >> 5; int tid = C.tid;
#if !defined(HOST_EMU)
    asm volatile("" : "+v"(tid));
#endif
    const int lane = tid & 63, w = tid >> 6, fr = lane & 15, fq = lane >> 4, vd = 16 * sl + fr; LAS unsigned char* L = C.lds;
    volatile LAS unsigned* RDY = (volatile LAS unsigned*)(L + SC_RDY); volatile LAS unsigned* PROG = (volatile LAS unsigned*)(L + SC_PROG);
    const int item0 = (b * NCH) * 8 + h;
    if (tid < 32) RDY[tid] = 0u;
    __syncthreads();
    if (w >= 1) {
        ScanLd ldA, ldB; int k = w - 1;
        if (k < NCH) scan_ld_issue(C, ldA, item0 + 8 * k, sl, lane);
        if (k + SC_D < NCH) scan_ld_issue(C, ldB, item0 + 8 * (k + SC_D), sl, lane);
        for (; k < NCH; k += 2 * SC_D) {
            while ((int)*PROG < k - SC_R + 1) SPIN_YIELD();
            scan_ld_write(ldA, L + (k % SC_R) * SC_SLOT, lane);
            WAVE_SYNC(); asm volatile("" ::: "memory");
            if (lane == 0) RDY[k % SC_R] = (unsigned)(k + 1);
            EMU_PROGRESS();
            if (k + 2 * SC_D < NCH) scan_ld_issue(C, ldA, item0 + 8 * (k + 2 * SC_D), sl, lane);
            const int k2 = k + SC_D;
            if (k2 < NCH) {
                while ((int)*PROG < k2 - SC_R + 1) SPIN_YIELD();
                scan_ld_write(ldB, L + (k2 % SC_R) * SC_SLOT, lane);
                WAVE_SYNC(); asm volatile("" ::: "memory");
                if (lane == 0) RDY[k2 % SC_R] = (unsigned)(k2 + 1);
                EMU_PROGRESS();
                if (k2 + 2 * SC_D < NCH) scan_ld_issue(C, ldB, item0 + 8 * (k2 + 2 * SC_D), sl, lane); }
        }
    } else {
        f32x4 S[4];
#pragma unroll
        for (int mt = 0; mt < 4; ++mt) S[mt] = (f32x4){0.f, 0.f, 0.f, 0.f};
        for (int c = 0; c < NCH; ++c) {
            const LAS unsigned char* slot = L + (c % SC_R) * SC_SLOT; const int item = item0 + 8 * c;
            while (RDY[c % SC_R] != (unsigned)(c + 1)) SPIN_YIELD();
            asm volatile("" ::: "memory");
            u32x2 m0[4], m1[4], m2[4], m3[4]; f32x4 gam[4], nn[4];
#pragma unroll
            for (int mt = 0; mt < 4; ++mt) { const LAS unsigned char* mr = slot + SC_M + (16 * mt + fr) * SC_MP + 8 * fq;
                m0[mt] = *(const LAS u32x2*)(mr); m1[mt] = *(const LAS u32x2*)(mr + 32); m2[mt] = *(const LAS u32x2*)(mr + 64); m3[mt] = *(const LAS u32x2*)(mr + 96);
                gam[mt] = *(const LAS f32x4*)(slot + SC_G + (16 * mt + 4 * fq) * 4); nn[mt] = up4(*(const LAS u32x2*)(slot + SC_N + fr * SC_NP + (16 * mt + 4 * fq) * 2)); }
            WAVE_SYNC(); asm volatile("" ::: "memory");
            if (lane == 0) *PROG = (unsigned)(c + 1);
            EMU_PROGRESS();
            GAS bf16* S0 = WSP(bf16, WS_CHS) + (size_t)item * 4096 + vd * 64; u32x2 sb[4];
#pragma unroll
            for (int mt = 0; mt < 4; ++mt) { sb[mt] = pk4(S[mt]); *(GAS u32x2*)(S0 + 16 * mt + 4 * fq) = sb[mt]; }
            const bf16x8 b0 = mk8(sb[0], sb[1]), b1 = mk8(sb[2], sb[3]);
#pragma unroll
            for (int mt = 0; mt < 4; ++mt) { f32x4 acc = gam[mt] * S[mt] + nn[mt]; acc = MFMA16(mk8(m0[mt], m1[mt]), b0, acc); acc = MFMA16(mk8(m2[mt], m3[mt]), b1, acc); S[mt] = acc; }
        }
        GAS float* So = GOUT + O_PS + (((size_t)(l * BATCH + b) * 8 + h) * 64 + vd) * 64;
#pragma unroll
        for (int mt = 0; mt < 4; ++mt) *(GAS f32x4*)(So + 16 * mt + 4 * fq) = S[mt];
    }
    __syncthreads();
}

constexpr int AT_K = 0, AT_VT = 256 * PB, VTP = 528, AT_END = AT_VT + 64 * VTP;
static_assert(AT_END <= 131072, "attention LDS map");
DEV void attn_item(const Ctx& C, int l, int item) {
#if !defined(HOST_EMU)
    asm volatile("" : "+v"(item));
#endif
    const int qb = item % NQB, kvh = (item / NQB) & 1, b = item / (2 * NQB);
    int tid = C.tid;
#if !defined(HOST_EMU)
    asm volatile("" : "+v"(tid));
#endif
    const int lane = tid & 63, w = tid >> 6, fr = lane & 15, fq = lane >> 4; LAS unsigned char* L = C.lds;
    const GAS bf16* proj = WSP(bf16, WS_PROJ); const GAS float* rope = WSP(float, WS_ROPE);
    constexpr float QSC = 0.125f * 1.4426950408889634f;
    const int hq = kvh * 4 + (w >> 1), half = w & 1; const float sink = GIN(I_SINK)[l * 8 + hq] * 1.4426950408889634f;
    u32x4 qlo[4], qhi[4]; f32x4 qc[4][2], qs[4][2];
#pragma unroll
    for (int nt = 0; nt < 4; ++nt) { const int qpos_ = qb * 128 + 64 * half + 16 * nt + fr; const GAS bf16* qp = proj + ((size_t)b * SEQ + qpos_) * IN_PROJ + A_PROJ + hq * 64 + 8 * fq; const GAS float* rp = rope + (size_t)qpos_ * 64 + 8 * fq;
        qlo[nt] = *(const GAS u32x4*)qp; qhi[nt] = *(const GAS u32x4*)(qp + 32); qc[nt][0] = *(const GAS f32x4*)rp; qc[nt][1] = *(const GAS f32x4*)(rp + 4); qs[nt][0] = *(const GAS f32x4*)(rp + 32); qs[nt][1] = *(const GAS f32x4*)(rp + 36); }
    {
        const int key = tid >> 1, p = tid & 1; const int kpos = (qb - 1) * 128 + key; const bool ok = kpos >= 0;
        const GAS bf16* kr = proj + (size_t)(b * SEQ + (ok ? kpos : 0)) * IN_PROJ + A_PROJ + 512 + kvh * 64; const GAS bf16* vr = kr + 128;
        const bool wr = (qb == NQB - 1) && key >= 128; GAS float* ok_ = GOUT + O_PK + (((size_t)(l * BATCH + b) * 128 + (key - 128)) * 2 + kvh) * 64; GAS float* ov_ = GOUT + O_PV + (((size_t)(l * BATCH + b) * 128 + (key - 128)) * 2 + kvh) * 64;
        u32x4 klo[2], khi[2], vv4[4]; f32x4 rc[2][2], rsn[2][2];
        const GAS float* rpb = rope + (size_t)(ok ? kpos : 0) * 64;
#pragma unroll
        for (int hh = 0; hh < 2; ++hh) { const int d0 = 16 * p + 8 * hh; klo[hh] = (u32x4){0u, 0u, 0u, 0u}; khi[hh] = klo[hh]; if (ok) { klo[hh] = *(const GAS u32x4*)(kr + d0); khi[hh] = *(const GAS u32x4*)(kr + 32 + d0); }
            rc[hh][0] = *(const GAS f32x4*)(rpb + d0); rc[hh][1] = *(const GAS f32x4*)(rpb + d0 + 4); rsn[hh][0] = *(const GAS f32x4*)(rpb + 32 + d0); rsn[hh][1] = *(const GAS f32x4*)(rpb + 32 + d0 + 4); }
#pragma unroll
        for (int hh = 0; hh < 4; ++hh) { vv4[hh] = (u32x4){0u, 0u, 0u, 0u}; if (ok) vv4[hh] = *(const GAS u32x4*)(vr + 32 * p + 8 * hh); }
#pragma unroll
        for (int hh = 0; hh < 2; ++hh) { const int d0 = 16 * p + 8 * hh;
            const u32x4 lo = klo[hh], hi = khi[hh];
            float x1[8], x2[8], y1[8], y2[8];
#pragma unroll
            for (int j = 0; j < 4; ++j) { x1[2 * j] = bf2f(lo[j]); x1[2 * j + 1] = bf2f(lo[j] >> 16); x2[2 * j] = bf2f(hi[j]); x2[2 * j + 1] = bf2f(hi[j] >> 16); }
#pragma unroll
            for (int j = 0; j < 8; ++j) { const float cs = rc[hh][j >> 2][j & 3], sn = rsn[hh][j >> 2][j & 3]; y1[j] = x1[j] * cs - x2[j] * sn; y2[j] = x2[j] * cs + x1[j] * sn; }
            u32x4 o1, o2;
#pragma unroll
            for (int j = 0; j < 4; ++j) { o1[j] = pk2(y1[2 * j], y1[2 * j + 1]); o2[j] = pk2(y2[2 * j], y2[2 * j + 1]); }
            *(LAS u32x4*)(L + AT_K + key * PB + d0 * 2) = o1; *(LAS u32x4*)(L + AT_K + key * PB + (32 + d0) * 2) = o2;
            if (wr) {
#pragma unroll
                for (int j = 0; j < 8; ++j) { ok_[d0 + j] = y1[j]; ok_[32 + d0 + j] = y2[j]; } } }
#pragma unroll
        for (int hh = 0; hh < 4; ++hh) { const int d0 = 32 * p + 8 * hh; const u32x4 vv = vv4[hh];
#pragma unroll
            for (int j = 0; j < 4; ++j) { *(LAS bf16*)(L + AT_VT + (d0 + 2 * j) * VTP + key * 2) = (bf16)(vv[j] & 0xffffu); *(LAS bf16*)(L + AT_VT + (d0 + 2 * j + 1) * VTP + key * 2) = (bf16)(vv[j] >> 16);
                if (wr) { ov_[d0 + 2 * j] = bf2f(vv[j]); ov_[d0 + 2 * j + 1] = bf2f(vv[j] >> 16); } } }
    }
    __syncthreads();
    {
#pragma unroll
        for (int nt = 0; nt < 4; ++nt) {
            const int i0 = 64 * half + 16 * nt, iq = i0 + fr, qpos = qb * 128 + iq, t0 = i0 >> 4; const size_t qrow = (size_t)b * SEQ + qpos;
            bf16x8 q0, q1;
            { const u32x4 lo = qlo[nt], hi = qhi[nt];
              u32x4 o1, o2;
#pragma unroll
              for (int j = 0; j < 4; ++j) { const float xa = bf2f(lo[j]), xb_ = bf2f(lo[j] >> 16), ya = bf2f(hi[j]), yb_ = bf2f(hi[j] >> 16);
                  const float c0 = qc[nt][j >> 1][(2 * j) & 3], s0 = qs[nt][j >> 1][(2 * j) & 3], c1 = qc[nt][j >> 1][(2 * j + 1) & 3], s1 = qs[nt][j >> 1][(2 * j + 1) & 3];
                  o1[j] = pk2((xa * c0 - ya * s0) * QSC, (xb_ * c1 - yb_ * s1) * QSC); o2[j] = pk2((ya * c0 + xa * s0) * QSC, (yb_ * c1 + xb_ * s1) * QSC); }
              q0 = __builtin_bit_cast(bf16x8, o1); q1 = __builtin_bit_cast(bf16x8, o2); }
            f32x4 s[9]; float mx = -INFINITY;
#pragma unroll
            for (int r = 0; r < 9; ++r) { const int kt = t0 + r; f32x4 a = {0.f, 0.f, 0.f, 0.f};
                a = MFMA16(ldfrag(L + AT_K, 16 * kt + fr, 0, fq), q0, a); a = MFMA16(ldfrag(L + AT_K, 16 * kt + fr, 1, fq), q1, a);
                if (r == 0) {
#pragma unroll
                    for (int e = 0; e < 4; ++e) a[e] = (4 * fq + e > fr) ? a[e] : -INFINITY; }
                if (r == 8) {
#pragma unroll
                    for (int e = 0; e < 4; ++e) a[e] = (4 * fq + e <= fr) ? a[e] : -INFINITY; }
                if (qb == 0 && kt < 8) a = (f32x4){-INFINITY, -INFINITY, -INFINITY, -INFINITY};
#pragma unroll
                for (int e = 0; e < 4; ++e) mx = fmaxf(mx, a[e]);
                s[r] = a; }
            mx = fmaxf(mx, SHFLX(mx, 16)); mx = fmaxf(mx, SHFLX(mx, 32)); mx = fmaxf(mx, sink);
            float den = 0.f;
#pragma unroll
            for (int r = 0; r < 9; ++r)
#pragma unroll
                for (int e = 0; e < 4; ++e) { const float pe = fexp2(s[r][e] - mx); s[r][e] = pe; den += pe; }
            den += SHFLX(den, 16); den += SHFLX(den, 32); den += fexp2(sink - mx);
            f32x4 o[4];
#pragma unroll
            for (int dt = 0; dt < 4; ++dt) o[dt] = (f32x4){0.f, 0.f, 0.f, 0.f};
            const u32x2 z2 = {0u, 0u};
#pragma unroll
            for (int pr = 0; pr < 5; ++pr) { const int ra = 2 * pr, rb = 2 * pr + 1;
                const bf16x8 pb = mk8(pk4(s[ra]), (rb < 9) ? pk4(s[rb < 9 ? rb : 8]) : z2);
#pragma unroll
                for (int dt = 0; dt < 4; ++dt) { const LAS unsigned char* vp = L + AT_VT + (16 * dt + fr) * VTP;
                    const u32x2 alo = *(const LAS u32x2*)(vp + (16 * (t0 + ra) + 4 * fq) * 2), ahi = (rb < 9) ? *(const LAS u32x2*)(vp + (16 * (t0 + (rb < 9 ? rb : 8)) + 4 * fq) * 2) : z2;
                    o[dt] = MFMA16(mk8(alo, ahi), pb, o[dt]); } }
            const float rden = 1.0f / den; GAS bf16* op = WSP(bf16, WS_MIX) + qrow * D + 512 + hq * 64 + 4 * fq;
#pragma unroll
            for (int dt = 0; dt < 4; ++dt) *(GAS u32x2*)(op + 16 * dt) = pk4(o[dt] * rden);
        }
    }
    __syncthreads();
}

struct OutTile { bf16x8 p0, p1; u32x2 w4[4], pa[4], pv[4], g[4]; float rk; };
DEV void out_tile_load(const Ctx& C, OutTile& t, int item, int tt, int h, int c, int b, int fr, int fq) {
    const GAS bf16* P = WSP(bf16, WS_CHP) + (size_t)item * 4096 + (16 * tt + fr) * 64; const GAS bf16* W4 = WSP(bf16, WS_CHW) + (size_t)item * 4096 + (16 * tt + fr) * 64;
    const int tok = 64 * c + 16 * tt + fr; const size_t row = (size_t)b * SEQ + tok; const bool hp = tok > 0;
    const GAS bf16* pr = WSP(bf16, WS_PROJ) + row * IN_PROJ + 1024 + h * 64 + 4 * fq; const GAS bf16* gp = WSP(bf16, WS_G) + row * 512 + h * 64 + 4 * fq;
    t.p0 = *(const GAS bf16x8*)(P + 8 * fq); t.p1 = *(const GAS bf16x8*)(P + 32 + 8 * fq); t.rk = WSP(float, WS_RKR)[row * 8 + h];
#pragma unroll
    for (int mt = 0; mt < 4; ++mt) { t.w4[mt] = *(const GAS u32x2*)(W4 + 16 * mt + 4 * fq); t.pa[mt] = *(const GAS u32x2*)(pr + 16 * mt); t.pv[mt] = (u32x2){0u, 0u}; if (hp) t.pv[mt] = *(const GAS u32x2*)(pr - IN_PROJ + 16 * mt); t.g[mt] = *(const GAS u32x2*)(gp + 16 * mt); }
}
DEV void rwkv_out_item(const Ctx& C, int l, int item, bool handoff) {
#if !defined(HOST_EMU)
    asm volatile("" : "+v"(item));
#endif
    const int h = item & 7, c = (item >> 3) % NCH, b = (item >> 3) / NCH, lane = C.tid & 63, fr = lane & 15, fq = lane >> 4;
    const GAS bf16* S0 = WSP(bf16, WS_CHS) + (size_t)item * 4096;
    bf16x8 s0a[4], s0b[4]; f32x4 lg[4], lb[4], mv[4];
#if !defined(HOST_EMU)
#define LD_S0(p) ({ const GAS unsigned long long* q_ = (const GAS unsigned long long*)(p); const unsigned long long x_ = __hip_atomic_load(q_, __ATOMIC_RELAXED, __HIP_MEMORY_SCOPE_AGENT), y_ = __hip_atomic_load(q_ + 1, __ATOMIC_RELAXED, __HIP_MEMORY_SCOPE_AGENT); \
        u32x4 v_; v_.x = (unsigned)x_; v_.y = (unsigned)(x_ >> 32); v_.z = (unsigned)y_; v_.w = (unsigned)(y_ >> 32); __builtin_bit_cast(bf16x8, v_); })
    if (handoff) {
#pragma unroll
        for (int mt = 0; mt < 4; ++mt) { s0a[mt] = LD_S0(S0 + (16 * mt + fr) * 64 + 8 * fq); s0b[mt] = LD_S0(S0 + (16 * mt + fr) * 64 + 32 + 8 * fq); }
    } else
#undef LD_S0
#endif
    {
#pragma unroll
        for (int mt = 0; mt < 4; ++mt) { s0a[mt] = *(const GAS bf16x8*)(S0 + (16 * mt + fr) * 64 + 8 * fq); s0b[mt] = *(const GAS bf16x8*)(S0 + (16 * mt + fr) * 64 + 32 + 8 * fq); }
    }
#pragma unroll
    for (int mt = 0; mt < 4; ++mt) { const int cc = l * 512 + h * 64 + 16 * mt + 4 * fq;
        lg[mt] = *(const GAS f32x4*)(GIN(I_LNG) + cc); lb[mt] = *(const GAS f32x4*)(GIN(I_LNB) + cc); mv[mt] = *(const GAS f32x4*)(GIN(I_MU) + (size_t)l * A_PROJ + 1024 + h * 64 + 16 * mt + 4 * fq); }
    OutTile ta, tb; out_tile_load(C, ta, item, 0, h, c, b, fr, fq);
#define OUT_TILE(T, TT) do { f32x4 y[4]; float s1 = 0.f; \
        _Pragma("unroll") for (int mt = 0; mt < 4; ++mt) { f32x4 acc = up4(T.w4[mt]); acc = MFMA16(s0a[mt], T.p0, acc); acc = MFMA16(s0b[mt], T.p1, acc); y[mt] = acc; s1 += (acc[0] + acc[1]) + (acc[2] + acc[3]); } \
        s1 += SHFLX(s1, 16); s1 += SHFLX(s1, 32); const float mean = s1 * (1.0f / 64.0f); float s2 = 0.f; \
        _Pragma("unroll") for (int mt = 0; mt < 4; ++mt) { const f32x4 d = y[mt] - mean; s2 += (d[0] * d[0] + d[1] * d[1]) + (d[2] * d[2] + d[3] * d[3]); } \
        s2 += SHFLX(s2, 16); s2 += SHFLX(s2, 32); const float rstd = frsq(s2 * (1.0f / 64.0f) + LNX_EPS); \
        GAS bf16* op = WSP(bf16, WS_MIX) + ((size_t)b * SEQ + 64 * c + 16 * (TT) + fr) * D + h * 64 + 4 * fq; \
        _Pragma("unroll") for (int mt = 0; mt < 4; ++mt) { const f32x4 pa = up4(T.pa[mt]), pv = up4(T.pv[mt]); const f32x4 v = pa + mv[mt] * (pv - pa), g = up4(T.g[mt]); \
            const f32x4 yn = (y[mt] - mean) * rstd * lg[mt] + lb[mt]; *(GAS u32x2*)(op + 16 * mt) = pk4((yn + T.rk * v) * g); } } while (0)
    out_tile_load(C, tb, item, 1, h, c, b, fr, fq); OUT_TILE(ta, 0);
    out_tile_load(C, ta, item, 2, h, c, b, fr, fq); OUT_TILE(tb, 1);
    out_tile_load(C, tb, item, 3, h, c, b, fr, fq); OUT_TILE(ta, 2);
    OUT_TILE(tb, 3);
#undef OUT_TILE
}
DEV void rwkv_out_ticket(const Ctx& C, int l, int j) {
    const int w = C.tid >> 6;
#define ORD_ITEM(o) ((((o) % (BATCH * 8)) >> 3) * NCH + (o) / (BATCH * 8)) * 8 + (((o) % (BATCH * 8)) & 7)
    rwkv_out_item(C, l, ORD_ITEM(8 * j + w), false);
#undef ORD_ITEM
}
DEV void final_rows2(GAS float* ra, GAS float* rb, const GAS bf16* sa_, const GAS bf16* sb_, const GAS float* gain, int lane) {
    GAS f32x4* ya = (GAS f32x4*)ra + lane; GAS f32x4* yb = (GAS f32x4*)rb + lane; const GAS u32x2* xa = (const GAS u32x2*)sa_ + lane; const GAS u32x2* xb_ = (const GAS u32x2*)sb_ + lane;
    u32x2 ua[4], ub[4]; f32x4 g[4]; float sa = 0.f, sb = 0.f;
#pragma unroll
    for (int j = 0; j < 4; ++j) { ua[j] = xa[64 * j]; ub[j] = xb_[64 * j]; g[j] = ((const GAS f32x4*)gain)[lane + 64 * j]; }
    f32x4 va[4], vb[4];
#pragma unroll
    for (int j = 0; j < 4; ++j) { va[j] = up4(ua[j]); vb[j] = up4(ub[j]); sa += (va[j][0] * va[j][0] + va[j][1] * va[j][1]) + (va[j][2] * va[j][2] + va[j][3] * va[j][3]); sb += (vb[j][0] * vb[j][0] + vb[j][1] * vb[j][1]) + (vb[j][2] * vb[j][2] + vb[j][3] * vb[j][3]); }
    const float rsa = frsq(wave_sum(sa) * (1.0f / D) + NORM_EPS), rsb = frsq(wave_sum(sb) * (1.0f / D) + NORM_EPS);
#pragma unroll
    for (int j = 0; j < 4; ++j) { NT_ST(ya + 64 * j, va[j] * rsa * g[j]); if (rb != ra) NT_ST(yb + 64 * j, vb[j] * rsb * g[j]); }
}
#ifdef NO_SK
#define SKINNY(...) do {} while (0)
#else
#define SKINNY(...) skinny_gemm(C.lds, __VA_ARGS__)
#endif
constexpr int N_PHASES = 2 + 7 * DEPTH;
template <int PH> DEV void run_phase(const Ctx& C0) {
    Ctx C = C0;
#if !defined(HOST_EMU)
    asm volatile("" : "+v"(C.tid)); asm volatile("" : "+s"(C.ws), "+s"(C.out));
    C.lane = C.tid & 63; C.wave = __builtin_amdgcn_readfirstlane(C.tid >> 6);
#endif
    const int gw = C.bid * NWAVES + C.wave, NGW = C.G * NWAVES;
    if constexpr (PH == 0) {
#ifndef NO_P0
        phase_prologue(C);
#ifdef DBL_P0
        phase_prologue(C);
#endif
#endif
    } else if constexpr (PH == N_PHASES - 1) {
        for (int m = gw; m < MR; m += 2 * NGW) { const int m2 = (m + NGW < MR) ? m + NGW : m;
            final_rows2(GOUT + (m < MP ? O_YP + (size_t)m * D : O_YS + (size_t)(m - MP) * D), GOUT + (m2 < MP ? O_YP + (size_t)m2 * D : O_YS + (size_t)(m2 - MP) * D), WSP(bf16, WS_XB) + (size_t)m * D, WSP(bf16, WS_XB) + (size_t)m2 * D, GIN(I_FINAL), C.lane); }

    } else {
        constexpr int l = (PH - 1) / 7, s = (PH - 1) % 7;
        GAS bf16* xb = WSP(bf16, WS_XB); GAS float* part = WSP(float, WS_PART); GAS bf16* proj = WSP(bf16, WS_PROJ); GAS bf16* mix = WSP(bf16, WS_MIX); GAS bf16* hid = WSP(bf16, WS_HID);
        if constexpr (s == 0) {
            pg8::Gemm g{xb, WSP(bf16, WS_WIN) + (size_t)l * INP * D, MP + 256, INP, D}; pg8::StaticOrder S; S.init(MP + 256, INP, C.G, C.bid);
            EpiProj E{proj, part, WSP(float, WS_PARTS)}; pg8::gemm_phase<EpiProj, pg8::StaticOrder, true, true>(C.lds, g, S, E, C.tid);
        } else if constexpr (s == 1) {
            for (int grp = C.bid; grp < NITEM / 8; grp += C.G) {
                u32x4 lc[5];
#pragma unroll
                for (int j = 0; j < 5; ++j) lc[j] = (u32x4){0u, 0u, 0u, 0u};
#pragma clang loop unroll(disable)
                for (int hh = 0; hh < 8; ++hh) {
#ifndef NO_R2
                    rwkv_prep_item(C, l, grp * 8 + hh, lc, hh == 0);
#endif
                } }
        } else if constexpr (s == 2) {
            constexpr int nscan = BATCH * 8 * 4;
#ifndef NO_R3
            for (int sv = C.bid; sv < nscan; sv += C.G) rwkv_scan_block(C, l, sv);
            if (C.bid < nscan)
#ifdef DBL_SCAN
            for (int sv = C.bid; sv < nscan; sv += C.G) rwkv_scan_block(C, l, sv);
#endif
#endif
            __syncthreads();
            GAS unsigned* qhead = (GAS unsigned*)(C.ws + WS_CTL) + 16384 + 64 * (2 * l + 1 + 2 * DEPTH * C.qsel); LAS unsigned* qslot = (LAS unsigned*)(C.lds + MISC_OFF + 64);
            constexpr int natt = BATCH * 2 * NQB, nlist = natt + MS;
            const int nb = C.G - nscan, cb = C.bid - nscan, nstat = (nb > 0) ? ((2 * nb < nlist) ? 2 * nb : nlist) : 0;
            int sk = 0;
            for (;;) {
                int e;
                if (cb >= 0 && sk < 2 && cb + sk * nb < nstat) { e = cb + sk * nb; ++sk; }
                else {
                    sk = 2;
                    if (C.tid == 0) *qslot = atomicAdd((unsigned*)qhead, 1u);
                    __syncthreads();
                    e = nstat + (int)*qslot;
                    __syncthreads(); }
                if (e >= nlist + MS) break;
                if (e < natt) attn_item(C, l, e);
                else if (e < nlist) sample_mix_item(C, l, e - natt, 0);
                else sample_mix_item(C, l, e - nlist, 1); }
        } else if constexpr (s == 3) { for (int j = C.bid; j < NITEM / 8; j += C.G) rwkv_out_ticket(C, l, j);
        } else if constexpr (s == 4) {
            pg8::Gemm g{mix, WSP(bf16, WS_WOUT) + (size_t)l * D * D, MP, D, D}; pg8::StaticOrder S; S.init(MP, D, C.G, C.bid);
            const bool skfirst = ((C.bid >> 3) & 1) != 0;
            SkResid<false> Es{GOUT + O_YS, xb + (size_t)MP * D, WSP(float, WS_PARTS)};
            if (skfirst) { skinny_gemm_k8<D>(C.lds, mix + (size_t)MP * D, WSP(bf16, WS_WOUT) + (size_t)l * D * D, D, Es, C.tid); __syncthreads(); }
            EpiResid<false> E{GOUT + O_YP, xb, part}; pg8::gemm_phase<EpiResid<false>, pg8::StaticOrder, true, true>(C.lds, g, S, E, C.tid);
            if (!skfirst) skinny_gemm_k8<D>(C.lds, mix + (size_t)MP * D, WSP(bf16, WS_WOUT) + (size_t)l * D * D, D, Es, C.tid);
        } else if constexpr (s == 6) {
            constexpr bool lastl = false;
            pg8::Gemm g{hid, WSP(bf16, WS_WDN) + (size_t)l * D * FF, MP, D, FF}; pg8::StaticOrder S; S.init(MP, D, C.G, C.bid);
            const bool skfirst = ((C.bid >> 3) & 1) != 0;
            SkResid<lastl> Es{GOUT + O_YS, xb + (size_t)MP * D, WSP(float, WS_PARTS)};
            if (skfirst) { skinny_gemm_k8<FF>(C.lds, hid + (size_t)MP * FF, WSP(bf16, WS_WDN) + (size_t)l * D * FF, D, Es, C.tid); __syncthreads(); }
            EpiResid<lastl> E{GOUT + O_YP, xb, part}; pg8::gemm_phase<EpiResid<lastl>, pg8::StaticOrder, true, true>(C.lds, g, S, E, C.tid);
            if (!skfirst) skinny_gemm_k8<FF>(C.lds, hid + (size_t)MP * FF, WSP(bf16, WS_WDN) + (size_t)l * D * FF, D, Es, C.tid);
        } else {
            { int G2 = (int)gridDim.x, me = (int)gridDim.x - 1 - (int)blockIdx.x;
#if !defined(HOST_EMU)
              asm volatile("" : "+s"(G2), "+s"(me));
#endif
              constexpr int nwg = ((MP + 256) / 256) * (GU / 256); const int nidle = ((nwg + G2 - 1) / G2) * G2 - nwg, nwk = (nidle > 0) ? nidle : G2;
              if (me < nwk) for (int it = me; it < 2 * MS; it += nwk) cache_shift_item(C, l, it); }
            pg8::Gemm g{xb, WSP(bf16, WS_WGU) + (size_t)l * GU * D, MP + 256, GU, D}; pg8::StaticOrder S; S.init(MP + 256, GU, C.G, C.bid);
            EpiGU E{hid, part, WSP(float, WS_PARTS)}; pg8::gemm_phase<EpiGU, pg8::StaticOrder, true, true>(C.lds, g, S, E, C.tid);
        }
    }
}
#if !defined(HOST_EMU)
#define GRID_BAR() xcd_barrier(bar)
#else
#define GRID_BAR() do {} while (0)
#endif
#if !defined(HOST_EMU)
template <int PH> DEV void run_from(const Ctx& C0, const int lo, const int hi, const XcdBarrier& bar) {
#else
template <int PH> DEV void run_from(const Ctx& C0, const int lo, const int hi, const int& bar) {
#endif
    if constexpr (PH < N_PHASES) {
        if (PH >= lo && PH < hi) { run_phase<PH>(C0);
#ifdef DBL_S
            if constexpr (PH >= 1 && PH < N_PHASES - 1 && ((PH - 1) % 7) == DBL_S) { GRID_BAR(); Ctx C1 = C0; C1.qsel = 1; run_phase<PH>(C1); }
#endif
#ifdef DBL_PH
            if constexpr (PH == DBL_PH) { GRID_BAR(); run_phase<PH>(C0); }
#endif
#ifdef XBAR
            if constexpr (PH >= 1 && PH < N_PHASES - 1 && ((PH - 1) % 7) == 3) { for (int xb_ = 0; xb_ < XBAR; ++xb_) GRID_BAR(); }
#endif
            if (PH + 1 < hi) GRID_BAR(); }
        run_from<PH + 1>(C0, lo, hi, bar);
    }
}
__global__ void __launch_bounds__(NWAVES * 64, 2) hybrid_fwd(Args args) {
#if defined(HOST_EMU)
    GAS unsigned char* lds = emu_lds;
#else
    extern __shared__ __attribute__((aligned(16))) unsigned char lds[];
#endif
    Ctx C; C.in = args.in; C.out = args.out; C.ws = args.ws; C.lds = (LAS unsigned char*)lds; C.tid = threadIdx.x; C.lane = C.tid & 63; C.wave = __builtin_amdgcn_readfirstlane(C.tid >> 6);
    C.G = gridDim.x; C.bid = blockIdx.x; C.qsel = 0;
#if !defined(HOST_EMU)
    volatile LAS unsigned* MISC = (volatile LAS unsigned*)(C.lds + MISC_OFF);
    for (int u = C.tid; u < (LDS_BYTES - 131072) / 4; u += NWAVES * 64) ((LAS unsigned*)(C.lds + 131072))[u] = 0u;
    __syncthreads();
    XcdBarrier bar = xcd_barrier_post((GAS unsigned*)(C.ws + WS_CTL) + 4096, MISC + 8);
#else
    int bar = 0;
#endif
    run_from<0>(C, args.ph_lo, args.ph_hi, bar);
}

extern "C" void kernel_launch(void* const* d_in, const int* in_sizes, int n_in, void* d_out, int out_size, void* d_ws, size_t ws_size, hipStream_t stream) {
    static int grid = 0;
    if (grid == 0) {
        if (n_in != N_IN || (size_t)out_size != O_END || ws_size < WS_END) { fprintf(stderr, "kernel_launch: shape mismatch: n_in %d out %d (want %zu) ws %zu (want %zu)\n", n_in, out_size, (size_t)O_END, ws_size, (size_t)WS_END); grid = -1; return; }
#if defined(HOST_EMU)
        grid = 3;
#else
        int dev = 0, cus = 0;
        if (hipGetDevice(&dev) != hipSuccess || hipDeviceGetAttribute(&cus, hipDeviceAttributeMultiprocessorCount, dev) != hipSuccess) { grid = -1; return; }
        if (hipFuncSetAttribute((const void*)hybrid_fwd, hipFuncAttributeMaxDynamicSharedMemorySize, LDS_BYTES) != hipSuccess) { fprintf(stderr, "kernel_launch: hipFuncSetAttribute failed\n"); grid = -1; return; }
        int per_cu = 0; (void)hipOccupancyMaxActiveBlocksPerMultiprocessor(&per_cu, (const void*)hybrid_fwd, NWAVES * 64, LDS_BYTES); (void)hipGetLastError();
        grid = cus;
#endif
    }
    if (grid < 0) return;
    (void)hipMemsetAsync((char*)d_ws + WS_CTL, 0, CTL_BYTES, stream);
    Args a; memset(&a, 0, sizeof(a));
    for (int i = 0; i < N_IN; ++i) a.in[i] = (const float*)d_in[i];
    a.out = (float*)d_out; a.ws = (unsigned char*)d_ws;
#if PH_PER_LAUNCH || defined(HOST_EMU)
    for (int ph = 0; ph < N_PHASES; ++ph) { a.ph_lo = ph; a.ph_hi = ph + 1;
#if defined(HOST_EMU)
        fprintf(stderr, "phase %d\n", ph); emu_launch([&] { hybrid_fwd(a); }, dim3(grid), dim3(NWAVES * 64), LDS_BYTES);
#else
        (void)hipMemsetAsync((char*)d_ws + WS_CTL, 0, CTL_BYTES, stream);
        hipLaunchKernelGGL(hybrid_fwd, dim3(grid), dim3(NWAVES * 64), LDS_BYTES, stream, a);
#endif
    }
#else
    a.ph_lo = 0; a.ph_hi = N_PHASES;
    hipLaunchKernelGGL(hybrid_fwd, dim3(grid), dim3(NWAVES * 64), LDS_BYTES, stream, a);
#endif
}
```
